# Optimizing an MI355X kernel written in HIP

```python
import jax, jax.numpy as jnp
from jax import lax
import numpy as np

D_MODEL = 1024
BATCH = 16
SEQ = 256
DEPTH = 2
DEC_BATCH = 8
DEC_SEQ = 4096
PAST_LEN = 256

GRID_W = 64
POOL_WINDOWS = (2, 4, 8, 16)
POOL_GROUPS = len(POOL_WINDOWS)
POOL_DIM = D_MODEL
POOL_GROUP_DIM = POOL_DIM // POOL_GROUPS
SSD_EXPAND = 2
D_INNER = SSD_EXPAND * D_MODEL
SSD_HEAD_DIM = 64
SSD_HEADS = D_INNER // SSD_HEAD_DIM
SSD_GROUPS = 4
SSD_STATE = 128
SSD_CONV = 4
SSD_CHUNK = 128
CONV_DIM = D_INNER + 2 * SSD_GROUPS * SSD_STATE
N_BRANCH = 2
IN_COLS = POOL_DIM + D_INNER + CONV_DIM + 2 * SSD_HEADS + N_BRANCH * D_MODEL
D_FF = 2816
N_MOD = 9
EPS = 1e-6

kernel_name = "hybrid_pool_ssd_diffusion_step"


def _rmsnorm(x, g):
    xf = x.astype(jnp.float32)
    y = xf * lax.rsqrt(jnp.mean(xf * xf, axis=-1, keepdims=True) + EPS)
    return (y * g.astype(jnp.float32)).astype(x.dtype)


def _modulate(x, g, shift, scale):
    return _rmsnorm(x, g) * (1 + scale) + shift


def _adaln(cond, w, b):
    mod = jax.nn.silu(cond) @ w + b
    return mod.reshape(cond.shape[0], N_MOD, 1, D_MODEL)


def _swiglu(h, w13, w2):
    g, u = jnp.split(h @ w13, 2, axis=-1)
    return (jax.nn.silu(g) * u) @ w2


def _dwconv_centred(u, w, b):
    K = w.shape[0]
    left = K // 2
    T = u.shape[1]
    up = jnp.pad(u, ((0, 0), (left, K - 1 - left), (0, 0)))
    out = b + up[:, 0:T] * w[0]
    for k in range(1, K):
        out = out + up[:, k:k + T] * w[k]
    return out


def _bounds(n, w):
    idx = jnp.arange(n)
    lo = jnp.clip(idx - w // 2, 0, n)
    hi = jnp.clip(idx - w // 2 + w, 0, n)
    return lo, hi


def _pool_seq(u, w):
    T = u.shape[1]
    s = jnp.pad(jnp.cumsum(u.astype(jnp.float32), axis=1), ((0, 0), (1, 0), (0, 0)))
    lo, hi = _bounds(T, w)
    cnt = (hi - lo).astype(jnp.float32)[None, :, None]
    return ((s[:, hi] - s[:, lo]) / cnt).astype(u.dtype)


def _pool_grid(u, w):
    R, W = u.shape[1], u.shape[2]
    s = jnp.cumsum(jnp.cumsum(u.astype(jnp.float32), axis=1), axis=2)
    s = jnp.pad(s, ((0, 0), (1, 0), (1, 0), (0, 0)))
    rlo, rhi = _bounds(R, w)
    clo, chi = _bounds(W, w)
    s_hi = s[:, rhi]
    s_lo = s[:, rlo]
    tot = (s_hi[:, :, chi] - s_hi[:, :, clo]) - (s_lo[:, :, chi] - s_lo[:, :, clo])
    cnt = ((rhi - rlo)[:, None] * (chi - clo)[None, :]).astype(jnp.float32)[None, :, :, None]
    return (tot / cnt).astype(u.dtype)


def _pool_mixer(u, pool_w, pool_scale, rows):
    b, T, _ = u.shape
    outs = []
    for g, w in enumerate(POOL_WINDOWS):
        ug = u[..., g * POOL_GROUP_DIM:(g + 1) * POOL_GROUP_DIM]
        if rows is None:
            pooled = _pool_seq(ug, w)
        else:
            pooled = _pool_grid(ug.reshape(b, rows, GRID_W, POOL_GROUP_DIM), w).reshape(b, T, POOL_GROUP_DIM)
        outs.append(pooled - ug)
    d = jnp.stack(outs, axis=2)
    y = jnp.einsum('btgc,gcd->btgd', d, pool_w).reshape(b, T, POOL_DIM)
    return y * pool_scale


def _ssd_scan(x, dt, a, bmat, cmat, h0):
    b, T, H, P = x.shape
    G, N = bmat.shape[2], bmat.shape[3]
    Hg = H // G
    L = SSD_CHUNK
    nc = T // L
    xf = (x.astype(jnp.float32) * dt[..., None]).reshape(b, nc, L, G, Hg, P)
    da = (dt * a).reshape(b, nc, L, G, Hg)
    bc = bmat.astype(jnp.float32).reshape(b, nc, L, G, N)
    cc = cmat.astype(jnp.float32).reshape(b, nc, L, G, N)
    cs = jnp.cumsum(da, axis=2)
    seg = cs[:, :, :, None] - cs[:, :, None]
    causal = jnp.tril(jnp.ones((L, L), dtype=bool))[:, :, None, None]
    decay = jnp.where(causal, jnp.exp(jnp.where(causal, seg, 0.0)), 0.0)
    scores = jnp.einsum('bclgn,bcsgn->bclsg', cc, bc)
    m = scores[..., None] * decay
    y_diag = jnp.einsum('bclsgh,bcsghp->bclghp', m, xf)
    xw = xf * jnp.exp(cs[:, :, -1:] - cs)[..., None]
    states = jnp.einsum('bclgn,bclghp->bcghpn', bc, xw)
    chunk_decay = jnp.exp(cs[:, :, -1])

    def step(h, inp):
        st, dec = inp
        return h * dec[..., None, None] + st, h

    h0g = h0.astype(jnp.float32).reshape(b, G, Hg, P, N)
    h_last, h_prev = lax.scan(step, h0g, (jnp.moveaxis(states, 1, 0), jnp.moveaxis(chunk_decay, 1, 0)))
    h_prev = jnp.moveaxis(h_prev, 0, 1)
    y_off = jnp.einsum('bclgn,bcghpn->bclghp', cc, h_prev) * jnp.exp(cs)[..., None]
    y = (y_diag + y_off).reshape(b, T, H, P)
    return y, h_last.reshape(b, H, P, N)


def _token_mixer(h, rows, h0_f, h0_b, lp):
    b, T, _ = h.shape
    proj = h @ lp['w_in']
    s1 = POOL_DIM
    s2 = s1 + D_INNER
    s3 = s2 + CONV_DIM
    s4 = s3 + 2 * SSD_HEADS
    u_pool, z, xbc, dt_raw, gates = jnp.split(proj, [s1, s2, s3, s4], axis=-1)
    y_pool = _pool_mixer(u_pool, lp['pool_w'], lp['pool_scale'], rows)
    xbc = jax.nn.silu(_dwconv_centred(xbc, lp['conv_w'], lp['conv_b']))
    xs, bm, cm = jnp.split(xbc, [D_INNER, D_INNER + SSD_GROUPS * SSD_STATE], axis=-1)
    xs = xs.reshape(b, T, SSD_HEADS, SSD_HEAD_DIM)
    bm = bm.reshape(b, T, SSD_GROUPS, SSD_STATE)
    cm = cm.reshape(b, T, SSD_GROUPS, SSD_STATE)
    dt = jax.nn.softplus(dt_raw.astype(jnp.float32).reshape(b, T, 2, SSD_HEADS) + lp['dt_bias'].astype(jnp.float32))
    a = -jnp.exp(lp['a_log'].astype(jnp.float32))
    y_f, hf = _ssd_scan(xs, dt[:, :, 0], a[0], bm, cm, h0_f)
    flip = lambda t: jnp.flip(t, axis=1)
    y_b, hb = _ssd_scan(flip(xs), flip(dt[:, :, 1]), a[1], flip(bm), flip(cm), h0_b)
    y = y_f + flip(y_b) + lp['d_skip'].astype(jnp.float32)[:, None] * xs.astype(jnp.float32)
    y = y.reshape(b, T, D_INNER).astype(h.dtype)
    y = _rmsnorm(y * jax.nn.silu(z), lp['ssd_norm'])
    g_a, g_b = jnp.split(jax.nn.sigmoid(gates), 2, axis=-1)
    merged = g_a * (y_pool @ lp['w_branch_pool']) + g_b * (y @ lp['w_branch_ssd'])
    return merged @ lp['w_out'], hf, hb


def _layer(x, mod, rows, h0_f, h0_b, lp):
    ng = lp['norm_g']
    x = x + 0.5 * mod[:, 2] * _swiglu(_modulate(x, ng[0], mod[:, 0], mod[:, 1]), lp['ffn1_w13'], lp['ffn1_w2'])
    m, hf, hb = _token_mixer(_modulate(x, ng[1], mod[:, 3], mod[:, 4]), rows, h0_f, h0_b, lp)
    x = x + mod[:, 5] * m
    x = x + 0.5 * mod[:, 8] * _swiglu(_modulate(x, ng[2], mod[:, 6], mod[:, 7]), lp['ffn2_w13'], lp['ffn2_w2'])
    return x, hf, hb


def setup_inputs(seed: int = 0) -> dict:
    key = jax.random.key(seed)
    ks = jax.random.split(key, 32)
    f32 = jnp.float32
    nrm = lambda k, shape, s: jax.random.normal(k, shape, f32) * s
    sd = (DEC_BATCH, DEPTH, SSD_HEADS, SSD_HEAD_DIM, SSD_STATE)
    dt0 = jnp.exp(jax.random.uniform(ks[17], (DEPTH, 2, SSD_HEADS), f32, np.log(1e-3), np.log(1e-1)))
    return {
        'x_prompt': nrm(ks[0], (BATCH, SEQ, D_MODEL), 1.0),
        'x_sample': nrm(ks[1], (DEC_BATCH, DEC_SEQ, D_MODEL), 1.0),
        'state_ssd_fwd': nrm(ks[2], sd, 0.5),
        'state_ssd_bwd': nrm(ks[3], sd, 0.5),
        'c': nrm(ks[4], (DEC_BATCH, D_MODEL), 1.0),
        'c_ctx': nrm(ks[5], (D_MODEL,), 1.0),
        'ada_w': nrm(ks[6], (DEPTH, D_MODEL, N_MOD * D_MODEL), D_MODEL ** -0.5),
        'ada_b': nrm(ks[7], (DEPTH, N_MOD * D_MODEL), 0.02),
        'norm_g': 1.0 + nrm(ks[8], (DEPTH, 3, D_MODEL), 0.02),
        'ffn1_w13': nrm(ks[9], (DEPTH, D_MODEL, 2 * D_FF), D_MODEL ** -0.5),
        'ffn1_w2': nrm(ks[10], (DEPTH, D_FF, D_MODEL), D_FF ** -0.5),
        'ffn2_w13': nrm(ks[11], (DEPTH, D_MODEL, 2 * D_FF), D_MODEL ** -0.5),
        'ffn2_w2': nrm(ks[12], (DEPTH, D_FF, D_MODEL), D_FF ** -0.5),
        'w_in': nrm(ks[13], (DEPTH, D_MODEL, IN_COLS), D_MODEL ** -0.5),
        'pool_w': nrm(ks[14], (DEPTH, POOL_GROUPS, POOL_GROUP_DIM, POOL_GROUP_DIM), POOL_GROUP_DIM ** -0.5),
        'pool_scale': 1.0 + nrm(ks[15], (DEPTH, POOL_DIM), 0.1),
        'conv_w': nrm(ks[16], (DEPTH, SSD_CONV, CONV_DIM), SSD_CONV ** -0.5),
        'conv_b': nrm(ks[18], (DEPTH, CONV_DIM), 0.02),
        'a_log': jnp.log(jax.random.uniform(ks[19], (DEPTH, 2, SSD_HEADS), f32, 1.0, 16.0)),
        'dt_bias': dt0 + jnp.log(-jnp.expm1(-dt0)),
        'd_skip': 1.0 + nrm(ks[20], (DEPTH, SSD_HEADS), 0.1),
        'ssd_norm': 1.0 + nrm(ks[21], (DEPTH, D_INNER), 0.02),
        'w_branch_pool': nrm(ks[22], (DEPTH, POOL_DIM, D_MODEL), POOL_DIM ** -0.5),
        'w_branch_ssd': nrm(ks[23], (DEPTH, D_INNER, D_MODEL), D_INNER ** -0.5),
        'w_out': nrm(ks[24], (DEPTH, D_MODEL, D_MODEL), D_MODEL ** -0.5),
        'final_norm': 1.0 + nrm(ks[25], (D_MODEL,), 0.02),
    }


def reference(x_prompt, x_sample, state_ssd_fwd, state_ssd_bwd, c, c_ctx, ada_w, ada_b, norm_g,
              ffn1_w13, ffn1_w2, ffn2_w13, ffn2_w2, w_in, pool_w, pool_scale, conv_w, conv_b,
              a_log, dt_bias, d_skip, ssd_norm, w_branch_pool, w_branch_ssd, w_out, final_norm):
    bp = x_prompt.shape[0]
    rows = x_sample.shape[1] // GRID_W
    zeros = jnp.zeros((bp, SSD_HEADS, SSD_HEAD_DIM, SSD_STATE), x_prompt.dtype)
    xc = x_prompt
    xl = x_sample
    new_f = []
    new_b = []
    for l in range(DEPTH):
        lp = {
            'norm_g': norm_g[l], 'ffn1_w13': ffn1_w13[l], 'ffn1_w2': ffn1_w2[l],
            'ffn2_w13': ffn2_w13[l], 'ffn2_w2': ffn2_w2[l], 'w_in': w_in[l],
            'pool_w': pool_w[l], 'pool_scale': pool_scale[l], 'conv_w': conv_w[l], 'conv_b': conv_b[l],
            'a_log': a_log[l], 'dt_bias': dt_bias[l], 'd_skip': d_skip[l], 'ssd_norm': ssd_norm[l],
            'w_branch_pool': w_branch_pool[l], 'w_branch_ssd': w_branch_ssd[l], 'w_out': w_out[l],
        }
        mod_ctx = _adaln(c_ctx[None, :], ada_w[l], ada_b[l])
        mod_lat = _adaln(c, ada_w[l], ada_b[l])
        xc, hf, hb = _layer(xc, mod_ctx, None, zeros, zeros, lp)
        new_f.append(hf.astype(x_prompt.dtype))
        new_b.append(hb.astype(x_prompt.dtype))
        xl, _, _ = _layer(xl, mod_lat, rows, state_ssd_fwd[:, l], state_ssd_bwd[:, l], lp)
    y_prompt = _rmsnorm(xc, final_norm)
    y_sample = _rmsnorm(xl, final_norm)
    new_state_fwd = jnp.stack(new_f, axis=1)
    new_state_bwd = jnp.stack(new_b, axis=1)
    return (y_prompt, y_sample, new_state_fwd, new_state_bwd)
```

```cpp
#include <hip/hip_runtime.h>
#include <hip/hip_cooperative_groups.h>
#include <cstdio>
#include <cstdint>
namespace pg8 {
#define PG8_LAS __attribute__((address_space(3)))
typedef unsigned short bf16_t;
typedef short bf16x8 __attribute__((ext_vector_type(8)));
typedef float f32x4 __attribute__((ext_vector_type(4)));
typedef unsigned u32x4 __attribute__((ext_vector_type(4)));
constexpr int BM = 256, BK = 64, HALF = 128, HTB = HALF * BK * 2  , STAGE_BYTES = 8 * HTB, NXCD = 8, WGM = 8;

__host__ __device__ __forceinline__ int lds_byte(int r, int c) { const int st = (r >> 4) * 2 + (c >> 5), rr = r & 15, cc = c & 31, ob = rr * 64 + cc * 2; return st * 1024 + (ob ^ (((ob >> 9) & 1) << 5)); }
__host__ __device__ __forceinline__ void stage_rc(int b, int& R, int& C) { const int st = b / 1024, sb = b % 1024, swz = sb ^ (((sb >> 9) & 1) << 5); R = (st >> 1) * 16 + swz / 64; C = (st & 1) * 32 + (swz % 64) / 2; }
__host__ __device__ __forceinline__ int perm32(int rho) { const int n = rho >> 4, i = rho & 15; return 8 * (i >> 2) + 4 * n + (i & 3); }

__device__ __forceinline__ float fexp(float x) { return __builtin_amdgcn_exp2f(x * 1.4426950408889634f); }
struct Unit { int pm, pn; };
struct Gemm { const bf16_t* A; const bf16_t* Bt; int M, N, K, lda, ldb, a_pn_bytes; };

struct StaticOrder {
    int nM, nN, nwg, G, c;
    __host__ __device__ void init(int M, int N, int G_, int c_) { nM = M / BM; nN = N / BM; nwg = nM * nN; G = G_; c = c_; }
    __host__ __device__ bool next(int i, Unit& u) const {
        const int L = i * G + c; if (L >= nwg) return false;
        int wgid = L; { const int q = nwg / NXCD, r = nwg % NXCD, xcd = wgid % NXCD, off = wgid / NXCD; wgid = (xcd < r ? xcd * (q + 1) : r * (q + 1) + (xcd - r) * q) + off; }
        const int nig = WGM * nN, gid = wgid / nig, fm = gid * WGM, gsz = (nM - fm) < WGM ? (nM - fm) : WGM;
        u.pm = fm + ((wgid % nig) % gsz); u.pn = (wgid % nig) / gsz; return true;
    }
    __device__ __forceinline__ void a_ready(const Unit&) const {}
    __device__ __forceinline__ void done(const Unit&) const {}
};

struct PanelOrder {
    int mode, c;
    __device__ __forceinline__ bool next(int i, Unit& u) const {
        const int xcd = c & 7, slot = c >> 3;
        if (mode == 0) { if (i >= 2) return false; u.pm = i * 64 + xcd * 8 + (slot >> 2); u.pn = slot & 3; return true; }
        if (i >= 1 || c < 0 || c >= 64) return false;
        u.pm = 128 + xcd * 2 + (slot >> 2); u.pn = slot & 3; return true;
    }
    __device__ __forceinline__ void a_ready(const Unit&) const {}
    __device__ __forceinline__ void done(const Unit&) const {}
};

__device__ __forceinline__ unsigned cvt_pk_bf16(float lo, float hi) { unsigned r; asm volatile("v_cvt_pk_bf16_f32 %0, %1, %2" : "=v"(r) : "v"(lo), "v"(hi)); return r; }

__device__ __forceinline__ float bf_lo(unsigned u) { return __uint_as_float(u << 16); }
__device__ __forceinline__ float bf_hi(unsigned u) { return __uint_as_float(u & 0xffff0000u); }
__device__ __forceinline__ float fsilu(float v) { return v * __builtin_amdgcn_rcpf(1.0f + fexp(-v)); }
__device__ __forceinline__ float fsigm(float v) { return __builtin_amdgcn_rcpf(1.0f + fexp(-v)); }
__device__ __forceinline__ float softplus_f(float x) { const float e = fexp(-fabsf(x)); const float l = e < 0.0078125f ? e * (1.0f + e * (-0.5f + e * 0.33333333f)) : (__builtin_amdgcn_logf(1.0f + e) * 0.69314718056f); return fmaxf(x, 0.f) + l; }

struct EpiSwiGLU {
    static constexpr bool PERM = true, AFTER_DRAIN = false;
    bf16_t* O; int ldc;
    __device__ __forceinline__ void operator()(const f32x4 (&acc)[2][2][4][2], const Unit& u, int wr, int wc, int fr, int fq) const {
        const int row0 = u.pm * BM + wr * 64 + fr, col0 = u.pn * HALF + wc * 32 + 8 * fq;
#pragma unroll
        for (int ai = 0; ai < 2; ++ai)
#pragma unroll
            for (int m = 0; m < 4; ++m) { bf16_t* rowp = O + (size_t)(row0 + ai * HALF + m * 16) * ldc + col0;
                float v[8];
#pragma unroll
                for (int n = 0; n < 2; ++n)
#pragma unroll
                    for (int i = 0; i < 4; ++i) v[n * 4 + i] = fsilu(acc[ai][0][m][n][i]) * acc[ai][1][m][n][i];
                u32x4 w; w.x = cvt_pk_bf16(v[0], v[1]); w.y = cvt_pk_bf16(v[2], v[3]); w.z = cvt_pk_bf16(v[4], v[5]); w.w = cvt_pk_bf16(v[6], v[7]);
                *(u32x4*)rowp = w; }
    }
};
struct EpiResid {
    static constexpr bool PERM = true, AFTER_DRAIN = false;
    const bf16_t* XB; bf16_t* XO; const float* xp; const float* xs; const float* mod; int gate_off; float scale; int pm0; int use_in;
    __device__ __forceinline__ void operator()(const f32x4 (&acc)[2][2][4][2], const Unit& u, int wr, int wc, int fr, int fq) const {
        const int pmg = u.pm + pm0;
        const int mrow = pmg < 16 ? 0 : 1 + ((pmg - 16) >> 4);
        const float* gate = mod + (size_t)mrow * 9216 + gate_off;
        const int col0 = u.pn * BM + wc * 32 + 8 * fq;
        const unsigned e0 = (unsigned)((wr * 64 + fr) * 1024 + col0);
        char* db = (char*)(XO + (size_t)pmg * 256 * 1024);
        if (use_in) {
            const char* sb = (const char*)(pmg < 16 ? xp + (size_t)pmg * 256 * 1024 : xs + (size_t)(pmg - 16) * 256 * 1024);
#pragma unroll
            for (int bj = 0; bj < 2; ++bj) {
                const f32x4 g0 = *(const f32x4*)(gate + col0 + bj * HALF) * scale, g1 = *(const f32x4*)(gate + col0 + bj * HALF + 4) * scale;
#pragma unroll
                for (int ai = 0; ai < 2; ++ai)
#pragma unroll
                  for (int mh = 0; mh < 4; mh += 4) {
                    f32x4 r0[4], r1[4];
                    unsigned eb = e0 + (unsigned)((ai * HALF + mh * 16) * 1024 + bj * HALF); asm volatile("" : "+v"(eb));
#pragma unroll
                    for (int m = 0; m < 4; ++m) { const unsigned e = eb + (unsigned)(m * 16 * 1024); r0[m] = *(const f32x4*)(sb + e * 4u); r1[m] = *(const f32x4*)(sb + e * 4u + 16u); }
#pragma unroll
                    for (int m = 0; m < 4; ++m) { const unsigned e = eb + (unsigned)(m * 16 * 1024);
                        const f32x4 v0 = r0[m] + g0 * acc[ai][bj][mh + m][0], v1 = r1[m] + g1 * acc[ai][bj][mh + m][1];
                        u32x4 w; w.x = cvt_pk_bf16(v0[0], v0[1]); w.y = cvt_pk_bf16(v0[2], v0[3]); w.z = cvt_pk_bf16(v1[0], v1[1]); w.w = cvt_pk_bf16(v1[2], v1[3]);
                        *(u32x4*)(db + e * 2u) = w; }
                    asm volatile("" ::: "memory");
                  }
            }
        } else {
            const char* sb = (const char*)(XB + (size_t)pmg * 256 * 1024);
#pragma unroll
            for (int bj = 0; bj < 2; ++bj) {
                const f32x4 g0 = *(const f32x4*)(gate + col0 + bj * HALF) * scale, g1 = *(const f32x4*)(gate + col0 + bj * HALF + 4) * scale;
                {
                    u32x4 r[2][4];
                    unsigned eb = e0 + (unsigned)(bj * HALF); asm volatile("" : "+v"(eb));
#pragma unroll
                    for (int ai = 0; ai < 2; ++ai)
#pragma unroll
                    for (int m = 0; m < 4; ++m) { const unsigned e = eb + (unsigned)((ai * HALF + m * 16) * 1024); r[ai][m] = *(const u32x4*)(sb + e * 2u); }
#pragma unroll
                    for (int ai = 0; ai < 2; ++ai)
#pragma unroll
                    for (int m = 0; m < 4; ++m) { const unsigned e = eb + (unsigned)((ai * HALF + m * 16) * 1024);
                        const u32x4 q = r[ai][m]; const f32x4 a0 = acc[ai][bj][m][0], a1 = acc[ai][bj][m][1];
                        u32x4 w;
                        w.x = cvt_pk_bf16(bf_lo(q.x) + g0[0] * a0[0], bf_hi(q.x) + g0[1] * a0[1]); w.y = cvt_pk_bf16(bf_lo(q.y) + g0[2] * a0[2], bf_hi(q.y) + g0[3] * a0[3]);
                        w.z = cvt_pk_bf16(bf_lo(q.z) + g1[0] * a1[0], bf_hi(q.z) + g1[1] * a1[1]); w.w = cvt_pk_bf16(bf_lo(q.w) + g1[2] * a1[2], bf_hi(q.w) + g1[3] * a1[3]);
                        *(u32x4*)(db + e * 2u) = w; }
                    asm volatile("" ::: "memory");
                }
            }
        }
    }
};
struct EpiDelta {
    static constexpr bool PERM = true, AFTER_DRAIN = false;
    bf16_t* D2; const float* mod; int gate_off; float scale;
    __device__ __forceinline__ void operator()(const f32x4 (&acc)[2][2][4][2], const Unit& u, int wr, int wc, int fr, int fq) const {
        const int mrow = u.pm < 16 ? 0 : 1 + ((u.pm - 16) >> 4);
        const float* gate = mod + (size_t)mrow * 9216 + gate_off;
        const int row0 = (u.pm - 128) * BM + wr * 64 + fr, col0 = u.pn * BM + wc * 32 + 8 * fq;
#pragma unroll
        for (int bj = 0; bj < 2; ++bj) {
            const f32x4 g0 = *(const f32x4*)(gate + col0 + bj * HALF) * scale, g1 = *(const f32x4*)(gate + col0 + bj * HALF + 4) * scale;
#pragma unroll
            for (int ai = 0; ai < 2; ++ai)
#pragma unroll
                for (int m = 0; m < 4; ++m) { const f32x4 v0 = acc[ai][bj][m][0] * g0, v1 = acc[ai][bj][m][1] * g1;
                    u32x4 w; w.x = cvt_pk_bf16(v0[0], v0[1]); w.y = cvt_pk_bf16(v0[2], v0[3]); w.z = cvt_pk_bf16(v1[0], v1[1]); w.w = cvt_pk_bf16(v1[2], v1[3]);
                    *(u32x4*)(D2 + (size_t)(row0 + ai * HALF + m * 16) * 1024 + col0 + bj * HALF) = w; }
        }
    }
};
struct EpiYZ {
    static constexpr bool PERM = true, AFTER_DRAIN = false;
    bf16_t* Y; int ldc; float* rowss;
    __device__ __forceinline__ void operator()(const f32x4 (&acc)[2][2][4][2], const Unit& u, int wr, int wc, int fr, int fq) const {
        const int row0 = u.pm * BM + wr * 64 + fr, col0 = u.pn * BM + wc * 32 + 8 * fq;
#pragma unroll
        for (int ai = 0; ai < 2; ++ai) {
            float ss[4] = {0.f, 0.f, 0.f, 0.f};
            unsigned eb = (unsigned)((row0 + ai * HALF) * ldc + col0); asm volatile("" : "+v"(eb));
            u32x4 yq[2][4];
#pragma unroll
            for (int bj = 0; bj < 2; ++bj)
#pragma unroll
                for (int m = 0; m < 4; ++m) yq[bj][m] = *(const u32x4*)((const char*)Y + ((size_t)eb + (size_t)(m * 16 * ldc + bj * HALF)) * 2u);
#pragma unroll
            for (int bj = 0; bj < 2; ++bj) {
#pragma unroll
                for (int m = 0; m < 4; ++m) { const f32x4 a0 = acc[ai][bj][m][0], a1 = acc[ai][bj][m][1]; const u32x4 q = yq[bj][m];
                    const float v0 = bf_lo(q.x) * fsilu(a0[0]), v1 = bf_hi(q.x) * fsilu(a0[1]), v2 = bf_lo(q.y) * fsilu(a0[2]), v3 = bf_hi(q.y) * fsilu(a0[3]);
                    const float v4 = bf_lo(q.z) * fsilu(a1[0]), v5 = bf_hi(q.z) * fsilu(a1[1]), v6 = bf_lo(q.w) * fsilu(a1[2]), v7 = bf_hi(q.w) * fsilu(a1[3]);
                    ss[m] += (v0 * v0 + v1 * v1) + (v2 * v2 + v3 * v3) + (v4 * v4 + v5 * v5) + (v6 * v6 + v7 * v7);
                    u32x4 w; w.x = cvt_pk_bf16(v0, v1); w.y = cvt_pk_bf16(v2, v3); w.z = cvt_pk_bf16(v4, v5); w.w = cvt_pk_bf16(v6, v7);
                    *(u32x4*)((char*)Y + ((size_t)eb + (size_t)(m * 16 * ldc + bj * HALF)) * 2u) = w; }
                asm volatile("" ::: "memory");
            }
#pragma unroll
            for (int m = 0; m < 4; ++m) { float s = ss[m]; s += __shfl_xor(s, 16); s += __shfl_xor(s, 32);
                if (fq == 0) atomicAdd(rowss + row0 + ai * HALF + m * 16, s); }
        }
    }
};
struct EpiStore {
    static constexpr bool PERM = true, AFTER_DRAIN = false;
    bf16_t* O; int ldc; int dt_pn; float* DT; const float* dtb; int split_pn; size_t split_stride;
    __device__ __forceinline__ void operator()(const f32x4 (&acc)[2][2][4][2], const Unit& u, int wr, int wc, int fr, int fq) const {
        const int row0 = u.pm * BM + wr * 64 + fr;
        if (u.pn == dt_pn) {
            if (wc < 2) {
                const int c0 = wc * 32 + 8 * fq;
                f32x4 b0 = *(const f32x4*)(dtb + c0), b1 = *(const f32x4*)(dtb + c0 + 4);
#pragma unroll
                for (int ai = 0; ai < 2; ++ai)
#pragma unroll
                    for (int m = 0; m < 4; ++m) { float* rowp = DT + (size_t)(row0 + ai * HALF + m * 16) * 64 + c0;
                        f32x4 v0 = acc[ai][0][m][0] + b0, v1 = acc[ai][0][m][1] + b1;
#pragma unroll
                        for (int i = 0; i < 4; ++i) { v0[i] = softplus_f(v0[i]); v1[i] = softplus_f(v1[i]); }
                        *(f32x4*)rowp = v0; *(f32x4*)(rowp + 4) = v1; }
            }
            return;
        }
        int pnl = u.pn; bf16_t* base = O;
        if (split_pn > 0) { const int t = u.pn / split_pn; pnl = u.pn - t * split_pn; base = O + (size_t)t * split_stride; }
        const int col0 = pnl * BM + wc * 32 + 8 * fq;
#pragma unroll
        for (int ai = 0; ai < 2; ++ai)
#pragma unroll
            for (int m = 0; m < 4; ++m) { bf16_t* rowp = base + (size_t)(row0 + ai * HALF + m * 16) * ldc + col0;
#pragma unroll
                for (int bj = 0; bj < 2; ++bj) { const f32x4 v0 = acc[ai][bj][m][0], v1 = acc[ai][bj][m][1];
                    u32x4 w; w.x = cvt_pk_bf16(v0[0], v0[1]); w.y = cvt_pk_bf16(v0[2], v0[3]); w.z = cvt_pk_bf16(v1[0], v1[1]); w.w = cvt_pk_bf16(v1[2], v1[3]);
                    *(u32x4*)(rowp + bj * HALF) = w; } }
    }
};
template <int MODE> struct EpiGate {
    static constexpr bool PERM = true, AFTER_DRAIN = false;
    static constexpr int MB = 4;
    bf16_t* O; int ldc; const float* cs; const bf16_t* G; int ldg; const float* rowss;
    __device__ __forceinline__ void operator()(const f32x4 (&acc)[2][2][4][2], const Unit& u, int wr, int wc, int fr, int fq) const {
        const int row0 = u.pm * BM + wr * 64 + fr, col0 = u.pn * BM + wc * 32 + 8 * fq;
#pragma unroll
        for (int bj = 0; bj < 2; ++bj) {
            f32x4 s0 = (f32x4){1.f, 1.f, 1.f, 1.f}, s1 = s0;
            if (MODE == 0) { s0 = *(const f32x4*)(cs + col0 + bj * HALF); s1 = *(const f32x4*)(cs + col0 + bj * HALF + 4); }
#pragma unroll
            for (int ai = 0; ai < 2; ++ai)
#pragma unroll
              for (int mh = 0; mh < 4; mh += MB) {
                u32x4 gq[4], oq[4]; float rsv[4] = {1.f, 1.f, 1.f, 1.f};
                if (MODE != 0) {
#pragma unroll
                    for (int m = mh; m < mh + MB; ++m) { const int row = row0 + ai * HALF + m * 16;
                        if (MODE == 3) rsv[m] = rowss[row];
                        gq[m] = *(const u32x4*)(G + (size_t)row * ldg + col0 + bj * HALF);
                        if (MODE == 2) oq[m] = *(const u32x4*)(O + (size_t)row * ldc + col0 + bj * HALF); }
                }
#pragma unroll
                for (int m = mh; m < mh + MB; ++m) { const int row = row0 + ai * HALF + m * 16; bf16_t* rowp = O + (size_t)row * ldc + col0 + bj * HALF;
                    const f32x4 a0 = acc[ai][bj][m][0], a1 = acc[ai][bj][m][1];
                    float v[8] = {a0[0], a0[1], a0[2], a0[3], a1[0], a1[1], a1[2], a1[3]};
                    if (MODE == 0) {
#pragma unroll
                        for (int i = 0; i < 4; ++i) { v[i] *= s0[i]; v[4 + i] *= s1[i]; } }
                    else { const unsigned gw[4] = {gq[m].x, gq[m].y, gq[m].z, gq[m].w};
                        const float rr = (MODE == 3) ? __builtin_amdgcn_rsqf((rsv[m] + 2048.0f * 1e-6f) * (1.0f / 2048.0f)) : 1.0f;
#pragma unroll
                        for (int i = 0; i < 4; ++i) { v[2 * i] *= fsigm(bf_lo(gw[i])) * rr; v[2 * i + 1] *= fsigm(bf_hi(gw[i])) * rr; }
                        if (MODE == 2) { const unsigned ow[4] = {oq[m].x, oq[m].y, oq[m].z, oq[m].w};
#pragma unroll
                            for (int i = 0; i < 4; ++i) { v[2 * i] += bf_lo(ow[i]); v[2 * i + 1] += bf_hi(ow[i]); } } }
                    u32x4 w; w.x = cvt_pk_bf16(v[0], v[1]); w.y = cvt_pk_bf16(v[2], v[3]); w.z = cvt_pk_bf16(v[4], v[5]); w.w = cvt_pk_bf16(v[6], v[7]);
                    *(u32x4*)rowp = w; }
                asm volatile("" ::: "memory");
            }
        }
    }
};

template <class Epi, class Sched>
__device__ __forceinline__ void gemm_phase(PG8_LAS unsigned char* lds_in, const Gemm g, const Sched& S, const Epi& E) {
    PG8_LAS unsigned char* lds = lds_in; { unsigned z_ = 0; asm volatile("" : "+s"(z_)); lds += z_; }
    int tid_ = threadIdx.x; asm volatile("" : "+v"(tid_));
    const int tid = tid_, wid = __builtin_amdgcn_readfirstlane(tid >> 6), lane = tid & 63, wr = wid >> 2, wc = wid & 3, fr = lane & 15, fq = lane >> 4;
    const int K = g.K, nt = K / BK, lda = g.lda, ldb = g.ldb;
    unsigned voffA[2], voffB[2];
#pragma unroll
    for (int i = 0; i < 2; ++i) { int R, C; stage_rc(tid * 16 + i * 8192, R, C); const int Rb = Epi::PERM ? ((R & ~31) + perm32(R & 31)) : R;
        voffA[i] = (unsigned)(R * lda + C) * 2u; voffB[i] = (unsigned)(Rb * ldb + C) * 2u; }
    const size_t kstep = (size_t)(BK * 2);
    const size_t hstepA = (size_t)HALF * lda * 2, hstepB = (size_t)HALF * ldb * 2, acol = (size_t)g.a_pn_bytes;
    const size_t tstepA = 2 * hstepA, tstepB = 2 * hstepB;
    const unsigned ldsw = (unsigned)wid * 1024u;
    const int aoff = lds_byte(wr * 64 + fr, fq * 8), boff = lds_byte(wc * 32 + fr, fq * 8);
#define PG8_SA(b, h) (((b) * 2 + (h)) * HTB)
#define PG8_SB(b, h) ((4 + (b) * 2 + (h)) * HTB)
#define PG8_STAGE(bufoff, gbase, voff) do { _Pragma("unroll") for (int _i = 0; _i < 2; ++_i) \
        __builtin_amdgcn_global_load_lds((const unsigned*)((const char*)(gbase) + (voff)[_i]), (PG8_LAS unsigned*)(lds + (bufoff) + ldsw + _i * 8192), 16, 0, 0); } while (0)
#define PG8_LDA(dst, b, h) do { _Pragma("unroll") for (int m = 0; m < 4; ++m) _Pragma("unroll") for (int k = 0; k < 2; ++k) dst[m][k] = *(const PG8_LAS bf16x8*)(lds + PG8_SA(b, h) + aoff + m * 2048 + k * 1024); } while (0)
#define PG8_LDB(dst, b, h) do { _Pragma("unroll") for (int n = 0; n < 2; ++n) _Pragma("unroll") for (int k = 0; k < 2; ++k) dst[n][k] = *(const PG8_LAS bf16x8*)(lds + PG8_SB(b, h) + boff + n * 2048 + k * 1024); } while (0)
#define PG8_MMA(ai, bj, At, Bt) do { __builtin_amdgcn_s_setprio(1); _Pragma("unroll") for (int m = 0; m < 4; ++m) _Pragma("unroll") for (int n = 0; n < 2; ++n) _Pragma("unroll") for (int k = 0; k < 2; ++k) \
        acc[ai][bj][m][n] = __builtin_amdgcn_mfma_f32_16x16x32_bf16(Bt[n][k], At[m][k], acc[ai][bj][m][n], 0, 0, 0); __builtin_amdgcn_s_setprio(0); } while (0)
#define PG8_WAIT_V(n) asm volatile("s_waitcnt vmcnt(" #n ")" ::: "memory")
#define PG8_WAIT_L(n) asm volatile("s_waitcnt lgkmcnt(" #n ")" ::: "memory")
#define PG8_BAR __builtin_amdgcn_s_barrier()
#define PG8_SCHED __builtin_amdgcn_sched_barrier(0)
    Unit cur, nxt; int ui = 0;
    if (!S.next(0, cur)) return;
    f32x4 acc[2][2][4][2];
#pragma unroll
    for (int a = 0; a < 2; ++a)
#pragma unroll
        for (int b = 0; b < 2; ++b)
#pragma unroll
            for (int m = 0; m < 4; ++m)
#pragma unroll
                for (int n = 0; n < 2; ++n) acc[a][b][m][n] = (f32x4){0.f, 0.f, 0.f, 0.f};
    bf16x8 At[4][2], B0[2][2], B1[2][2];
    const char* cA = (const char*)g.A + (size_t)cur.pm * tstepA + (size_t)cur.pn * acol; const char* cB = (const char*)g.Bt + (size_t)cur.pn * tstepB;
    S.a_ready(cur);
    PG8_STAGE(PG8_SB(0, 0), cB, voffB); PG8_STAGE(PG8_SA(0, 0), cA, voffA); PG8_STAGE(PG8_SB(0, 1), cB + hstepB, voffB); PG8_STAGE(PG8_SA(0, 1), cA + hstepA, voffA);
    if (wr == 1) PG8_BAR;
    PG8_WAIT_V(4); PG8_BAR;
    PG8_STAGE(PG8_SB(1, 0), cB + kstep, voffB); PG8_STAGE(PG8_SA(1, 0), cA + kstep, voffA); PG8_STAGE(PG8_SB(1, 1), cB + hstepB + kstep, voffB);
    PG8_WAIT_V(6); PG8_BAR;
    for (;;) {
        const bool has_next = S.next(ui + 1, nxt);
        const char* nA = has_next ? (const char*)g.A + (size_t)nxt.pm * tstepA + (size_t)nxt.pn * acol : cA; const char* nB = has_next ? (const char*)g.Bt + (size_t)nxt.pn * tstepB : cB;
        for (int t = 0; t < nt; t += 2) {
            const bool last = (t == nt - 2);
            const char* a1 = cA + (size_t)(t + 1) * kstep;
            const char* a2 = last ? nA : cA + (size_t)(t + 2) * kstep; const char* b2 = last ? nB : cB + (size_t)(t + 2) * kstep;
            const char* a3 = a2 + kstep; const char* b3 = b2 + kstep;
            if (last && has_next) S.a_ready(nxt);
            PG8_LDB(B0, 0, 0); PG8_SCHED; PG8_LDA(At, 0, 0); PG8_STAGE(PG8_SA(1, 1), a1 + hstepA, voffA);
            PG8_WAIT_L(8); PG8_BAR; PG8_WAIT_L(0); PG8_MMA(0, 0, At, B0); PG8_BAR; PG8_SCHED;
            PG8_LDB(B1, 0, 1); PG8_STAGE(PG8_SB(0, 0), b2, voffB);
            PG8_BAR; PG8_WAIT_L(0); PG8_MMA(0, 1, At, B1); PG8_BAR;
            PG8_LDA(At, 0, 1); PG8_STAGE(PG8_SA(0, 0), a2, voffA);
            PG8_BAR; PG8_WAIT_L(0); PG8_MMA(1, 0, At, B0); PG8_BAR; PG8_SCHED;
            PG8_STAGE(PG8_SB(0, 1), b2 + hstepB, voffB);
            PG8_WAIT_V(6); PG8_BAR; PG8_MMA(1, 1, At, B1); PG8_BAR;
            PG8_LDB(B0, 1, 0); PG8_SCHED; PG8_LDA(At, 1, 0); PG8_STAGE(PG8_SA(0, 1), a2 + hstepA, voffA);
            PG8_WAIT_L(8); PG8_BAR; PG8_WAIT_L(0); PG8_MMA(0, 0, At, B0); PG8_BAR; PG8_SCHED;
            PG8_LDB(B1, 1, 1); PG8_STAGE(PG8_SB(1, 0), b3, voffB);
            PG8_BAR; PG8_WAIT_L(0); PG8_MMA(0, 1, At, B1); PG8_BAR;
            PG8_LDA(At, 1, 1); PG8_STAGE(PG8_SA(1, 0), a3, voffA);
            PG8_BAR; PG8_WAIT_L(0); PG8_MMA(1, 0, At, B0); PG8_BAR; PG8_SCHED;
            PG8_STAGE(PG8_SB(1, 1), b3 + hstepB, voffB);
            PG8_WAIT_V(6); PG8_BAR; PG8_MMA(1, 1, At, B1); PG8_BAR;
        }
        if constexpr (!Epi::AFTER_DRAIN) { E(acc, cur, wr, wc, fr, fq); S.done(cur); }
        if (!has_next) break;
#pragma unroll
        for (int a = 0; a < 2; ++a)
#pragma unroll
            for (int b = 0; b < 2; ++b)
#pragma unroll
                for (int m = 0; m < 4; ++m)
#pragma unroll
                    for (int n = 0; n < 2; ++n) acc[a][b][m][n] = (f32x4){0.f, 0.f, 0.f, 0.f};
        cur = nxt; cA = nA; cB = nB; ++ui;
    }
    PG8_WAIT_V(0);
    if (wr == 0) PG8_BAR;
    PG8_BAR;
    if constexpr (Epi::AFTER_DRAIN) { E.fused(acc, cur, wr, wc, fr, fq, lds, wid, lane); S.done(cur); }
#undef PG8_SA
#undef PG8_SB
#undef PG8_STAGE
#undef PG8_LDA
#undef PG8_LDB
#undef PG8_MMA
#undef PG8_WAIT_V
#undef PG8_WAIT_L
#undef PG8_BAR
#undef PG8_SCHED
}
}

namespace cg = cooperative_groups;
using pg8::fexp;
#define LAS __attribute__((address_space(3)))
typedef unsigned short bf16;
typedef short bf16x8 __attribute__((ext_vector_type(8)));
typedef short s16x4 __attribute__((ext_vector_type(4)));
typedef float f32x4 __attribute__((ext_vector_type(4)));
typedef unsigned u32x4 __attribute__((ext_vector_type(4)));
typedef unsigned u32x2 __attribute__((ext_vector_type(2)));

constexpr int DM = 1024, T_CTX = 4096, T_LAT = 32768, T_ALL = T_CTX + T_LAT, DFF = 2816, DIN = 2048, CONVD = 3072, NHEAD = 32;
constexpr int NWAVES = 8, NTHR = 512;
constexpr int LDS_BYTES = 131072 + 256;
constexpr size_t WS_BAR = 768 * 1024, BAR_ZERO_BYTES = 16384;
constexpr size_t WS_ROWSS = 800 * 1024;
constexpr float EPS = 1e-6f;
constexpr size_t MiB = 1u << 20;
constexpr size_t WS_MOD = 0;
constexpr size_t WS_W = 1 * MiB;
constexpr size_t WO_W13A = 0, WO_W2A = 11534336, WO_W13B = 17301504, WO_W2B = 28835840, WO_WINA = 34603008, WO_WINB = 41418752, WO_PW = 51904512, WO_WBP = 52428800, WO_WBS = 54525952, WO_WO = 58720256;
constexpr size_t WS_H = 60 * MiB, WS_RA = 132 * MiB, WS_RB = 348 * MiB, WS_DT = 492 * MiB, WS_D2 = 501 * MiB, WS_END = 509 * MiB;
constexpr int NA_ROWS = 3328, NB_ROWS = 5120;
constexpr size_t RA_Z = 0, RA_U = 0, RA_GA = 72 * MiB, RA_GB = 144 * MiB, RA_MG = RA_U;
constexpr size_t RA_XH = 0, RA_BG = (size_t)32 * 36864 * 64 * 2, RA_CG = RA_BG + (size_t)4 * 36864 * 128 * 2;
constexpr size_t OUT_SF = (size_t)T_ALL * DM, OUT_SB = OUT_SF + 16 * 2 * 32 * 64 * 128;

__device__ __forceinline__ unsigned f2bf(float f) { unsigned u = __float_as_uint(f); return (u + 0x7fffu + ((u >> 16) & 1u)) >> 16; }
__device__ __forceinline__ unsigned pk2(float lo, float hi) { return pg8::cvt_pk_bf16(lo, hi); }
__device__ __forceinline__ float blo(unsigned u) { return __uint_as_float(u << 16); }
__device__ __forceinline__ float bhi(unsigned u) { return __uint_as_float(u & 0xffff0000u); }
__device__ __forceinline__ float wave_sum(float v) {
#pragma unroll
    for (int o = 1; o < 64; o <<= 1) v += __shfl_xor(v, o);
    return v;
}
__device__ __forceinline__ float silu_f(float v) { return v * __builtin_amdgcn_rcpf(1.0f + fexp(-v)); }

struct Args {
    const float* in[26];
    float* out; unsigned char* ws;
};

__device__ __forceinline__ void transpose_item(const float* W, int ldw, int K, bf16* WT, int n0, int c0, int k0, LAS float* scr, int lane, const float* kscale = nullptr) {
    const int c = lane & 7;
    if (c0 < 0) {
#pragma unroll
        for (int j = 0; j < 4; ++j) { const int n = (lane >> 3) + 8 * j; *(u32x4*)(WT + (size_t)(n0 + n) * K + k0 + 8 * c) = (u32x4){0u, 0u, 0u, 0u}; }
        return;
    }
    float wv[32];
#pragma unroll
    for (int i = 0; i < 32; ++i) { const int kk = 2 * i + (lane >> 5); wv[i] = W[(size_t)(k0 + kk) * ldw + c0 + (lane & 31)]; if (kscale) wv[i] *= kscale[k0 + kk]; }
#pragma unroll
    for (int i = 0; i < 32; ++i) { const int kk = 2 * i + (lane >> 5); scr[kk * 33 + (lane & 31)] = wv[i]; }
    asm volatile("s_waitcnt lgkmcnt(0)" ::: "memory");
#pragma unroll
    for (int j = 0; j < 4; ++j) { const int n = (lane >> 3) + 8 * j; const LAS float* s = scr + (8 * c) * 33 + n;
        u32x4 o; o.x = pk2(s[0 * 33], s[1 * 33]); o.y = pk2(s[2 * 33], s[3 * 33]); o.z = pk2(s[4 * 33], s[5 * 33]); o.w = pk2(s[6 * 33], s[7 * 33]);
        *(u32x4*)(WT + (size_t)(n0 + n) * K + k0 + 8 * c) = o; }
    asm volatile("s_waitcnt lgkmcnt(0)" ::: "memory");
}
__device__ __forceinline__ void convert_phase(const Args& a, int l, LAS unsigned char* lds, int gw, int ngw, int wave, int lane) {
    unsigned char* wsb = a.ws; asm volatile("" : "+s"(wsb));
    { unsigned z_ = 0; asm volatile("" : "+s"(z_)); lds += z_; }
    LAS float* scr = (LAS float*)(lds + wave * 8448);
    unsigned char* wb = wsb + WS_W;
    constexpr int I13 = 16 * 176, I2 = 44 * 32, IA = 16 * 104, IB = 16 * 160, IPW = 128, IBP = 16 * 32, IBS = 32 * 32, IWO = 16 * 32;
    constexpr int NITEMS = 2 * I13 + 2 * I2 + IA + IB + IPW + IBP + IBS + IWO;
    for (int it = gw; it < NITEMS; it += ngw) {
        int r = it;
        if (r < 2 * I13) { const int which = r / I13; r -= which * I13; const int kb = r / 176, nb = r % 176, n0 = nb * 32, tile = n0 >> 8, j0 = n0 & 255;
            const int c0 = j0 < 128 ? 128 * tile + j0 : DFF + 128 * tile + (j0 - 128);
            transpose_item(a.in[which ? 11 : 9] + (size_t)l * DM * 2 * DFF, 2 * DFF, DM, (bf16*)(wb + (which ? WO_W13B : WO_W13A)), n0, c0, kb * 64, scr, lane); continue; }
        r -= 2 * I13;
        if (r < 2 * I2) { const int which = r / I2; r -= which * I2; const int kb = r / 32, nb = r % 32;
            transpose_item(a.in[which ? 12 : 10] + (size_t)l * DFF * DM, DM, DFF, (bf16*)(wb + (which ? WO_W2B : WO_W2A)), nb * 32, nb * 32, kb * 64, scr, lane); continue; }
        r -= 2 * I2;
        const float* win = a.in[13] + (size_t)l * DM * 8256;
        if (r < IA) { const int kb = r / 104, nb = r % 104, n0 = nb * 32; const int c0 = n0 < 3136 ? 3072 + n0 : -1;
            transpose_item(win, 8256, DM, (bf16*)(wb + WO_WINA), n0, c0, kb * 64, scr, lane); continue; }
        r -= IA;
        if (r < IB) { const int kb = r / 160, nb = r % 160, n0 = nb * 32; const int c0 = n0 < 2048 ? 1024 + n0 : (n0 < 3072 ? n0 - 2048 : n0 + 3136);
            transpose_item(win, 8256, DM, (bf16*)(wb + WO_WINB), n0, c0, kb * 64, scr, lane); continue; }
        r -= IB;
        if (r < IPW) { const int g = r / 32; r -= g * 32; const int kb = r / 8, nb = r % 8;
            transpose_item(a.in[14] + (size_t)(l * 4 + g) * 65536, 256, 256, (bf16*)(wb + WO_PW) + (size_t)g * 65536, nb * 32, nb * 32, kb * 64, scr, lane); continue; }
        r -= IPW;
        if (r < IBP) { const int kb = r / 32, nb = r % 32;
            transpose_item(a.in[22] + (size_t)l * DM * DM, DM, DM, (bf16*)(wb + WO_WBP), nb * 32, nb * 32, kb * 64, scr, lane); continue; }
        r -= IBP;
        if (r < IBS) { const int kb = r / 32, nb = r % 32;
            transpose_item(a.in[23] + (size_t)l * DIN * DM, DM, DIN, (bf16*)(wb + WO_WBS), nb * 32, nb * 32, kb * 64, scr, lane, a.in[21] + (size_t)l * DIN); continue; }
        r -= IBS;
        { const int kb = r / 32, nb = r % 32;
            transpose_item(a.in[24] + (size_t)l * DM * DM, DM, DM, (bf16*)(wb + WO_WO), nb * 32, nb * 32, kb * 64, scr, lane); }
    }
}
__device__ __forceinline__ void adaln_phase(const Args& a, LAS unsigned char* lds, int tid) {
    unsigned char* wsb = a.ws; asm volatile("" : "+s"(wsb));
    { unsigned z_ = 0; asm volatile("" : "+s"(z_)); lds += z_; }
    LAS float* sc = (LAS float*)lds;
    LAS float* red = (LAS float*)(lds + 36864);
    float* MOD = (float*)(wsb + WS_MOD);
    if ((int)blockIdx.x >= 288) return;
    for (int i = tid; i < 9 * 1024; i += NTHR) { const int r = i >> 10, k = i & 1023; const float v = r == 0 ? a.in[5][k] : a.in[4][(r - 1) * 1024 + k]; sc[i] = silu_f(v); }
    __syncthreads();
    const int cgp = tid & 15, kc = tid >> 4;
    for (int item = blockIdx.x; item < 288; item += gridDim.x) {
        const int l = item / 144, cgi = item % 144, col0 = cgi * 64 + 4 * cgp;
        const float* w = a.in[6] + ((size_t)l * 1024 + kc * 32) * 9216 + col0;
        f32x4 acc[9];
#pragma unroll
        for (int r = 0; r < 9; ++r) acc[r] = (f32x4){0.f, 0.f, 0.f, 0.f};
#pragma unroll 16
        for (int i = 0; i < 32; ++i) { const f32x4 w4 = *(const f32x4*)(w + (size_t)i * 9216);
#pragma unroll
            for (int r = 0; r < 9; ++r) acc[r] += w4 * sc[r * 1024 + kc * 32 + i]; }
#pragma unroll
        for (int r = 0; r < 9; ++r) *(LAS f32x4*)(red + (kc * 9 + r) * 64 + 4 * cgp) = acc[r];
        __syncthreads();
        for (int o = tid; o < 576; o += NTHR) { const int r = o >> 6, c = o & 63; float s = 0.f;
#pragma unroll 8
            for (int k = 0; k < 32; ++k) s += red[(k * 9 + r) * 64 + c];
            MOD[((size_t)l * 9 + r) * 9216 + cgi * 64 + c] = s + a.in[7][(size_t)l * 9216 + cgi * 64 + c]; }
        __syncthreads();
    }
}
__device__ __forceinline__ void normmod_phase(const Args& a, int l, int idx, bool use_in, bool has_d2, int gw, int ngw, int lane) {
    unsigned char* wsb = a.ws; asm volatile("" : "+s"(wsb));
    const float* MOD = (const float*)(wsb + WS_MOD) + (size_t)l * 9 * 9216;
    bf16* XB = (bf16*)a.out; bf16* H = (bf16*)(wsb + WS_H); const bf16* D2 = (const bf16*)(wsb + WS_D2);
    const float* gp = a.in[8] + ((size_t)l * 3 + idx) * DM;
    f32x4 gv[2][2];
#pragma unroll
    for (int j = 0; j < 2; ++j) { gv[j][0] = *(const f32x4*)(gp + 8 * (lane + 64 * j)); gv[j][1] = *(const f32x4*)(gp + 8 * (lane + 64 * j) + 4); }
    constexpr int R = 3;
    const int rpw = (((T_ALL + ngw - 1) / ngw + R - 1) / R) * R;
    const int rbeg = gw * rpw, rend = min(rbeg + rpw, T_ALL);
    int cur_mrow = -1; f32x4 gsc[2][2], shv[2][2];
#pragma unroll
    for (int j = 0; j < 2; ++j) { gsc[j][0] = gv[j][0]; gsc[j][1] = gv[j][1]; shv[j][0] = gv[j][0]; shv[j][1] = gv[j][1]; }
    for (int r0 = rbeg; r0 < rend; r0 += R) {
        f32x4 v[R][2][2]; float s[R];
        if (use_in) {
#pragma unroll
            for (int r = 0; r < R; ++r) { const int row = r0 + r;
                const float* srcp = row < T_CTX ? a.in[0] + (size_t)row * DM : a.in[1] + (size_t)(row - T_CTX) * DM;
#pragma unroll
                for (int j = 0; j < 2; ++j) { v[r][j][0] = *(const f32x4*)(srcp + 8 * (lane + 64 * j)); v[r][j][1] = *(const f32x4*)(srcp + 8 * (lane + 64 * j) + 4); } }
        } else {
            u32x4 q[R][2];
#pragma unroll
            for (int r = 0; r < R; ++r)
#pragma unroll
                for (int j = 0; j < 2; ++j) q[r][j] = *(const u32x4*)(XB + (size_t)(r0 + r) * DM + 8 * (lane + 64 * j));
#pragma unroll
            for (int r = 0; r < R; ++r)
#pragma unroll
                for (int j = 0; j < 2; ++j) { v[r][j][0] = (f32x4){blo(q[r][j].x), bhi(q[r][j].x), blo(q[r][j].y), bhi(q[r][j].y)}; v[r][j][1] = (f32x4){blo(q[r][j].z), bhi(q[r][j].z), blo(q[r][j].w), bhi(q[r][j].w)}; }
            if (has_d2 && r0 + R - 1 >= 32768) {
#pragma unroll
                for (int r = 0; r < R; ++r) { const int row = r0 + r;
                    if (row >= 32768) {
#pragma unroll
                        for (int j = 0; j < 2; ++j) { const u32x4 d = *(const u32x4*)(D2 + (size_t)(row - 32768) * DM + 8 * (lane + 64 * j));
                            v[r][j][0] += (f32x4){blo(d.x), bhi(d.x), blo(d.y), bhi(d.y)}; v[r][j][1] += (f32x4){blo(d.z), bhi(d.z), blo(d.w), bhi(d.w)};
                            u32x4 w; w.x = pk2(v[r][j][0].x, v[r][j][0].y); w.y = pk2(v[r][j][0].z, v[r][j][0].w); w.z = pk2(v[r][j][1].x, v[r][j][1].y); w.w = pk2(v[r][j][1].z, v[r][j][1].w);
                            *(u32x4*)(XB + (size_t)row * DM + 8 * (lane + 64 * j)) = w;
                            v[r][j][0] = (f32x4){blo(w.x), bhi(w.x), blo(w.y), bhi(w.y)}; v[r][j][1] = (f32x4){blo(w.z), bhi(w.z), blo(w.w), bhi(w.w)}; } } }
            }
        }
#pragma unroll
        for (int r = 0; r < R; ++r) { s[r] = 0.f;
#pragma unroll
            for (int j = 0; j < 2; ++j)
#pragma unroll
                for (int h = 0; h < 2; ++h) s[r] += (v[r][j][h].x * v[r][j][h].x + v[r][j][h].y * v[r][j][h].y) + (v[r][j][h].z * v[r][j][h].z + v[r][j][h].w * v[r][j][h].w); }
#pragma unroll
        for (int o = 1; o < 64; o <<= 1) {
#pragma unroll
            for (int r = 0; r < R; ++r) s[r] += __shfl_xor(s[r], o); }
#pragma unroll
        for (int r = 0; r < R; ++r) { const int row = r0 + r;
            const int mrow = row < T_CTX ? 0 : 1 + ((row - T_CTX) >> 12);
            if (mrow != cur_mrow) {
                cur_mrow = mrow;
                const float* sh = MOD + (size_t)mrow * 9216 + (3 * idx) * DM;
                const float* scl = MOD + (size_t)mrow * 9216 + (3 * idx + 1) * DM;
#pragma unroll
                for (int j = 0; j < 2; ++j)
#pragma unroll
                    for (int h = 0; h < 2; ++h) { gsc[j][h] = gv[j][h] * (*(const f32x4*)(scl + 8 * (lane + 64 * j) + 4 * h) + 1.0f); shv[j][h] = *(const f32x4*)(sh + 8 * (lane + 64 * j) + 4 * h); }
            }
            const float rstd = __builtin_amdgcn_rsqf((s[r] + EPS * DM) * (1.f / DM));
#pragma unroll
            for (int j = 0; j < 2; ++j) { const f32x4 h0 = (v[r][j][0] * rstd) * gsc[j][0] + shv[j][0], h1 = (v[r][j][1] * rstd) * gsc[j][1] + shv[j][1];
                u32x4 w; w.x = pk2(h0.x, h0.y); w.y = pk2(h0.z, h0.w); w.z = pk2(h1.x, h1.y); w.w = pk2(h1.z, h1.w);
                *(u32x4*)(H + (size_t)row * DM + 8 * (lane + 64 * j)) = w; } }
    }
}
__device__ __forceinline__ void final_norm_phase(const Args& a, bool has_d2, int gw, int ngw, int lane) {
    unsigned char* wsb = a.ws; asm volatile("" : "+s"(wsb));
    float* OUT = a.out; const bf16* XW = (const bf16*)(wsb + WS_RB); const bf16* D2 = (const bf16*)(wsb + WS_D2);
    const float* gp = a.in[25];
    f32x4 gv[2][2];
#pragma unroll
    for (int j = 0; j < 2; ++j) { gv[j][0] = *(const f32x4*)(gp + 8 * (lane + 64 * j)); gv[j][1] = *(const f32x4*)(gp + 8 * (lane + 64 * j) + 4); }
    constexpr int R = 3;
    for (int r0 = gw * R; r0 < T_ALL; r0 += ngw * R) {
        u32x4 q[R][2]; f32x4 v[R][2][2]; float s[R];
#pragma unroll
        for (int r = 0; r < R; ++r)
#pragma unroll
            for (int j = 0; j < 2; ++j) q[r][j] = *(const u32x4*)(XW + (size_t)(r0 + r) * DM + 8 * (lane + 64 * j));
#pragma unroll
        for (int r = 0; r < R; ++r)
#pragma unroll
            for (int j = 0; j < 2; ++j) { v[r][j][0] = (f32x4){blo(q[r][j].x), bhi(q[r][j].x), blo(q[r][j].y), bhi(q[r][j].y)}; v[r][j][1] = (f32x4){blo(q[r][j].z), bhi(q[r][j].z), blo(q[r][j].w), bhi(q[r][j].w)}; }
        if (has_d2 && r0 + R - 1 >= 32768) {
#pragma unroll
            for (int r = 0; r < R; ++r) if (r0 + r >= 32768) {
#pragma unroll
                for (int j = 0; j < 2; ++j) { const u32x4 d = *(const u32x4*)(D2 + (size_t)(r0 + r - 32768) * DM + 8 * (lane + 64 * j));
                    v[r][j][0] += (f32x4){blo(d.x), bhi(d.x), blo(d.y), bhi(d.y)}; v[r][j][1] += (f32x4){blo(d.z), bhi(d.z), blo(d.w), bhi(d.w)}; } }
        }
#pragma unroll
        for (int r = 0; r < R; ++r) { s[r] = 0.f;
#pragma unroll
            for (int j = 0; j < 2; ++j)
#pragma unroll
                for (int h = 0; h < 2; ++h) s[r] += (v[r][j][h].x * v[r][j][h].x + v[r][j][h].y * v[r][j][h].y) + (v[r][j][h].z * v[r][j][h].z + v[r][j][h].w * v[r][j][h].w); }
#pragma unroll
        for (int o = 1; o < 64; o <<= 1) {
#pragma unroll
            for (int r = 0; r < R; ++r) s[r] += __shfl_xor(s[r], o); }
#pragma unroll
        for (int r = 0; r < R; ++r) { const float rstd = __builtin_amdgcn_rsqf((s[r] + EPS * DM) * (1.f / DM)); float* orow = OUT + (size_t)(r0 + r) * DM;
#pragma unroll
            for (int j = 0; j < 2; ++j) { *(f32x4*)(orow + 8 * (lane + 64 * j)) = v[r][j][0] * rstd * gv[j][0]; *(f32x4*)(orow + 8 * (lane + 64 * j) + 4) = v[r][j][1] * rstd * gv[j][1]; } }
    }
}
__device__ __forceinline__ void unpack8(const u32x4 q, float (&f)[8]) { f[0] = blo(q.x); f[1] = bhi(q.x); f[2] = blo(q.y); f[3] = bhi(q.y); f[4] = blo(q.z); f[5] = bhi(q.z); f[6] = blo(q.w); f[7] = bhi(q.w); }
__device__ __forceinline__ u32x4 pack8(const float (&f)[8]) { u32x4 w; w.x = pk2(f[0], f[1]); w.y = pk2(f[2], f[3]); w.z = pk2(f[4], f[5]); w.w = pk2(f[6], f[7]); return w; }
__device__ __forceinline__ void conv_phase(const Args& a, int l, int t_begin, int t_count, int raw_off, int gw, int ngw, int lane) {
    unsigned char* wsb = a.ws; asm volatile("" : "+s"(wsb));
    const bf16* RAW = (const bf16*)(wsb + WS_RB); bf16* XH = (bf16*)(wsb + WS_RA + RA_XH); bf16* BG = (bf16*)(wsb + WS_RA + RA_BG); bf16* CG = (bf16*)(wsb + WS_RA + RA_CG);
    const int nitems = (t_count / 16) * 6;
    int convd = CONVD; asm volatile("" : "+s"(convd));
    for (int it = gw; it < nitems; it += ngw) {
        const int cb = it % 6, run = it / 6, t0 = t_begin + run * 16, ch = cb * 512 + lane * 8;
        int s0, e0; if (t0 < T_CTX) { s0 = t0 & ~255; e0 = s0 + 256; } else { s0 = T_CTX + ((t0 - T_CTX) & ~4095); e0 = s0 + 4096; }
        float w[4][8], b[8];
#pragma unroll
        for (int k = 0; k < 4; ++k) { const f32x4 w0 = *(const f32x4*)(a.in[16] + ((size_t)l * 4 + k) * CONVD + ch), w1 = *(const f32x4*)(a.in[16] + ((size_t)l * 4 + k) * CONVD + ch + 4);
            w[k][0] = w0.x; w[k][1] = w0.y; w[k][2] = w0.z; w[k][3] = w0.w; w[k][4] = w1.x; w[k][5] = w1.y; w[k][6] = w1.z; w[k][7] = w1.w; }
        { const f32x4 b0 = *(const f32x4*)(a.in[17] + (size_t)l * CONVD + ch), b1 = *(const f32x4*)(a.in[17] + (size_t)l * CONVD + ch + 4);
            b[0] = b0.x; b[1] = b0.y; b[2] = b0.z; b[3] = b0.w; b[4] = b1.x; b[5] = b1.y; b[6] = b1.z; b[7] = b1.w; }
        bf16* dst; int dstride;
        if (ch < 2048) { dst = XH + (size_t)(ch >> 6) * T_ALL * 64 + (ch & 63); dstride = 64; }
        else if (ch < 2560) { dst = BG + (size_t)((ch - 2048) >> 7) * T_ALL * 128 + ((ch - 2048) & 127); dstride = 128; }
        else { dst = CG + (size_t)((ch - 2560) >> 7) * T_ALL * 128 + ((ch - 2560) & 127); dstride = 128; }
        u32x4 rw[19];
#pragma unroll
        for (int i = 0; i < 19; ++i) { const int t = t0 - 2 + i; rw[i] = (t >= s0 && t < e0) ? *(const u32x4*)(RAW + (size_t)(t - t_begin + raw_off) * convd + ch) : (u32x4){0u, 0u, 0u, 0u}; }
        float xm2[8], xm1[8], x0[8], xp1[8];
        unpack8(rw[0], xm2); unpack8(rw[1], xm1); unpack8(rw[2], x0);
#pragma unroll
        for (int i = 0; i < 16; ++i) {
            unpack8(rw[i + 3], xp1);
            float o[8];
#pragma unroll
            for (int c = 0; c < 8; ++c) { const float v = b[c] + w[0][c] * xm2[c] + w[1][c] * xm1[c] + w[2][c] * x0[c] + w[3][c] * xp1[c]; o[c] = silu_f(v); }
            *(u32x4*)(dst + (size_t)(t0 + i) * dstride) = pack8(o);
#pragma unroll
            for (int c = 0; c < 8; ++c) { xm2[c] = xm1[c]; xm1[c] = x0[c]; x0[c] = xp1[c]; }
        }
    }
}
template <int W>
__device__ __forceinline__ void hpool_g(const bf16* U, bf16* HS, int g, int gt, int ngt) {
    const int n = T_ALL * 32;
    for (int i = gt; i < n; i += ngt) {
        const int t = i >> 5, chunk = g * 32 + (i & 31);
        const bool ctx = t < T_CTX;
        const int c = ctx ? (t & 255) : ((t - T_CTX) & 63), lim = ctx ? 256 : 64;
        u32x4 q[W];
#pragma unroll
        for (int j = 0; j < W; ++j) { const int cc = c - W / 2 + j; const bool ok = (unsigned)cc < (unsigned)lim;
            q[j] = ok ? *(const u32x4*)(U + (size_t)(t - c + cc) * DM + chunk * 8) : (u32x4){0u, 0u, 0u, 0u}; }
        float s[8] = {0.f, 0.f, 0.f, 0.f, 0.f, 0.f, 0.f, 0.f};
#pragma unroll
        for (int j = 0; j < W; ++j) { float f[8]; unpack8(q[j], f);
#pragma unroll
            for (int k = 0; k < 8; ++k) s[k] += f[k]; }
        *(u32x4*)(HS + (size_t)t * DM + chunk * 8) = pack8(s);
    }
}
__device__ __forceinline__ void hpool_phase(const Args& a, int gt, int ngt) {
    unsigned char* wsb = a.ws; asm volatile("" : "+s"(wsb));
    const bf16* U = (const bf16*)(wsb + WS_RA + RA_U); bf16* HS = (bf16*)(wsb + WS_H);
    hpool_g<2>(U, HS, 0, gt, ngt); hpool_g<4>(U, HS, 1, gt, ngt); hpool_g<8>(U, HS, 2, gt, ngt); hpool_g<16>(U, HS, 3, gt, ngt);
}
template <int W>
__device__ __forceinline__ void vpool_g(bf16* U, const bf16* HS, int g, int gt, int ngt) {
    const int n = T_ALL * 32;
    for (int i = gt; i < n; i += ngt) {
        const int t = i >> 5, chunk = g * 32 + (i & 31);
        float s[8] = {0.f, 0.f, 0.f, 0.f, 0.f, 0.f, 0.f, 0.f}; float cnt;
        if (t < T_CTX) {
            const int p = t & 255;
            unpack8(*(const u32x4*)(HS + (size_t)t * DM + chunk * 8), s);
            cnt = (float)(min(p - W / 2 + W, 256) - max(p - W / 2, 0));
        } else {
            const int pos = (t - T_CTX) & 4095, c = pos & 63, r = pos >> 6;
            u32x4 q[W];
#pragma unroll
            for (int j = 0; j < W; ++j) { const int rr = r - W / 2 + j; const bool ok = (unsigned)rr < 64u;
                q[j] = ok ? *(const u32x4*)(HS + (size_t)(t + (rr - r) * 64) * DM + chunk * 8) : (u32x4){0u, 0u, 0u, 0u}; }
#pragma unroll
            for (int j = 0; j < W; ++j) { float f[8]; unpack8(q[j], f);
#pragma unroll
                for (int k = 0; k < 8; ++k) s[k] += f[k]; }
            cnt = (float)((min(r - W / 2 + W, 64) - max(r - W / 2, 0)) * (min(c - W / 2 + W, 64) - max(c - W / 2, 0)));
        }
        float u[8]; unpack8(*(const u32x4*)(U + (size_t)t * DM + chunk * 8), u);
        const float inv = 1.0f / cnt;
#pragma unroll
        for (int k = 0; k < 8; ++k) s[k] = s[k] * inv - u[k];
        *(u32x4*)(U + (size_t)t * DM + chunk * 8) = pack8(s);
    }
}
__device__ __forceinline__ void vpool_phase(const Args& a, int gt, int ngt) {
    unsigned char* wsb = a.ws; asm volatile("" : "+s"(wsb));
    bf16* U = (bf16*)(wsb + WS_RA + RA_U); const bf16* HS = (const bf16*)(wsb + WS_H);
    vpool_g<2>(U, HS, 0, gt, ngt); vpool_g<4>(U, HS, 1, gt, ngt); vpool_g<8>(U, HS, 2, gt, ngt); vpool_g<16>(U, HS, 3, gt, ngt);
}
__device__ __forceinline__ void gatednorm_phase(const Args& a, int l, int gw, int ngw, int lane) {
    const bf16* Z = (const bf16*)(a.ws + WS_RA + RA_Z); bf16* Y = (bf16*)(a.ws + WS_RB);
    const float* g = a.in[21] + (size_t)l * DIN;
    constexpr int R = 2;
    for (int t0 = gw * R; t0 < T_ALL; t0 += ngw * R) {
        u32x4 yq[R][4], zq[R][4];
#pragma unroll
        for (int r = 0; r < R; ++r) { const bf16* yr = Y + (size_t)(t0 + r) * DIN; const bf16* zr = Z + (size_t)(t0 + r) * DIN;
#pragma unroll
            for (int j = 0; j < 4; ++j) { yq[r][j] = *(const u32x4*)(yr + (j * 64 + lane) * 8); zq[r][j] = *(const u32x4*)(zr + (j * 64 + lane) * 8); } }
        float s[R];
#pragma unroll
        for (int r = 0; r < R; ++r) { s[r] = 0.f;
#pragma unroll
            for (int j = 0; j < 4; ++j) { float y[8], z[8]; unpack8(yq[r][j], y); unpack8(zq[r][j], z);
#pragma unroll
                for (int k = 0; k < 8; ++k) { y[k] = y[k] * silu_f(z[k]); s[r] += y[k] * y[k]; }
                yq[r][j] = (u32x4){__float_as_uint(y[0]), __float_as_uint(y[1]), __float_as_uint(y[2]), __float_as_uint(y[3])};
                zq[r][j] = (u32x4){__float_as_uint(y[4]), __float_as_uint(y[5]), __float_as_uint(y[6]), __float_as_uint(y[7])}; } }
#pragma unroll
        for (int o = 1; o < 64; o <<= 1) {
#pragma unroll
            for (int r = 0; r < R; ++r) s[r] += __shfl_xor(s[r], o); }
#pragma unroll
        for (int r = 0; r < R; ++r) { const float rstd = __builtin_amdgcn_rsqf(s[r] * (1.f / DIN) + EPS); bf16* yr = Y + (size_t)(t0 + r) * DIN;
#pragma unroll
            for (int j = 0; j < 4; ++j) { const f32x4 g0 = *(const f32x4*)(g + (j * 64 + lane) * 8), g1 = *(const f32x4*)(g + (j * 64 + lane) * 8 + 4);
                float o[8] = {__uint_as_float(yq[r][j].x) * rstd * g0.x, __uint_as_float(yq[r][j].y) * rstd * g0.y, __uint_as_float(yq[r][j].z) * rstd * g0.z, __uint_as_float(yq[r][j].w) * rstd * g0.w,
                              __uint_as_float(zq[r][j].x) * rstd * g1.x, __uint_as_float(zq[r][j].y) * rstd * g1.y, __uint_as_float(zq[r][j].z) * rstd * g1.z, __uint_as_float(zq[r][j].w) * rstd * g1.w};
                *(u32x4*)(yr + (j * 64 + lane) * 8) = pack8(o); } }
    }
}
constexpr int RS_BC = 272, RS_X = 160;
constexpr int L_BI = 0, L_CI = 34816, L_XI = 69632, L_HI = 90112, L_CS = 110592, L_DTV = L_CS + 512, L_WV = L_CS + 1024, L_TOT = L_CS + 1536;
__device__ __forceinline__ s16x4 trd(LAS unsigned char* p) { return __builtin_amdgcn_ds_read_tr16_b64_v4i16((LAS s16x4*)p); }
__device__ __forceinline__ bf16x8 cat4(s16x4 a, s16x4 b) { return (bf16x8){a[0], a[1], a[2], a[3], b[0], b[1], b[2], b[3]}; }
#define MFMA16(A, B, C) __builtin_amdgcn_mfma_f32_16x16x32_bf16((A), (B), (C), 0, 0, 0)

template <bool BWD>
__device__ __forceinline__ void ssd_sweep(LAS unsigned char* lds, const bf16* XH, const bf16* BG, const bf16* CG, const float* DT, bf16* YH, int tok0, int nc, int h, float aneg, float dskip,
                                          const float* h0, float* hout, int tid, int wave, int lane) {
    const int grp = h >> 3, dcol = (BWD ? 32 : 0) + h, scanw = BWD ? 7 : 0;
    const int cl = lane & 15, g = lane >> 4, q4 = (lane & 15) >> 2, pp = lane & 3;
    const int lcol = 16 * wave + cl;
    f32x4 hacc[4];
#pragma unroll
    for (int pt = 0; pt < 4; ++pt)
#pragma unroll
        for (int j = 0; j < 4; ++j) hacc[pt][j] = h0 ? h0[(size_t)(16 * pt + 4 * g + j) * 128 + lcol] : 0.f;
    u32x4 st[10]; float dts0 = 0.f, dts1 = 0.f; u32x2 yprev[4] = {(u32x2){0u, 0u}, (u32x2){0u, 0u}, (u32x2){0u, 0u}, (u32x2){0u, 0u}};
#define SSD_SB() __builtin_amdgcn_sched_barrier(0)
#define SSD_LOAD_CHUNK(c_) do { const int tokc_ = tok0 + (c_) * 128; \
        _Pragma("unroll") for (int r = 0; r < 2; ++r) { const int q = tid + 512 * r, row = q >> 3, c16 = q & 7; st[r] = *(const u32x4*)(XH + ((size_t)h * T_ALL + tokc_ + row) * 64 + c16 * 8); } \
        _Pragma("unroll") for (int r = 0; r < 4; ++r) { const int q = tid + 512 * r, row = q >> 4, c16 = q & 15; st[2 + r] = *(const u32x4*)(BG + ((size_t)grp * T_ALL + tokc_ + row) * 128 + c16 * 8); } \
        _Pragma("unroll") for (int r = 0; r < 4; ++r) { const int q = tid + 512 * r, row = q >> 4, c16 = q & 15; st[6 + r] = *(const u32x4*)(CG + ((size_t)grp * T_ALL + tokc_ + row) * 128 + c16 * 8); } \
        if (wave == scanw) { dts0 = DT[(size_t)(tokc_ + lane) * 64 + dcol]; dts1 = DT[(size_t)(tokc_ + 64 + lane) * 64 + dcol]; } \
        if (!BWD) { const bf16* yq = YH + (size_t)(tokc_ + lcol) * DIN + h * 64 + 4 * g; _Pragma("unroll") for (int pt = 0; pt < 4; ++pt) yprev[pt] = *(const u32x2*)(yq + 16 * pt); } \
    } while (0)
#define SSD_SCAN(cb_) do { if (wave == scanw) { \
        const float da0 = dts0 * aneg, da1 = dts1 * aneg; float p0 = da0, p1 = da1; \
        _Pragma("unroll") for (int o = 1; o < 64; o <<= 1) { const float t0 = __shfl_up(p0, o), t1 = __shfl_up(p1, o); if (lane >= o) { p0 += t0; p1 += t1; } } \
        const float tot0 = __shfl(p0, 63), tot1 = __shfl(p1, 63), total = tot0 + tot1; p1 += tot0; \
        const float c0 = BWD ? total - p0 + da0 : p0, c1 = BWD ? total - p1 + da1 : p1; \
        LAS float* CS = (LAS float*)(lds + (cb_)); \
        CS[lane] = c0; CS[64 + lane] = c1; CS[128 + lane] = dts0; CS[192 + lane] = dts1; \
        CS[256 + lane] = dts0 * fexp(total - c0); CS[320 + lane] = dts1 * fexp(total - c1); \
        if (lane == 0) CS[384] = total; } } while (0)
    SSD_LOAD_CHUNK(BWD ? nc - 1 : 0);
    SSD_SCAN(L_CS);
    for (int step = 0; step < nc; ++step) {
        const int c = BWD ? nc - 1 - step : step;
        const int tokc = tok0 + c * 128;
        const int csb = L_CS + (step & 1) * 2048;
#pragma unroll
        for (int r = 0; r < 2; ++r) { const int q = tid + 512 * r, row = q >> 3, c16 = q & 7; *(LAS u32x4*)(lds + L_XI + row * RS_X + c16 * 16) = st[r]; }
#pragma unroll
        for (int r = 0; r < 4; ++r) { const int q = tid + 512 * r, row = q >> 4, c16 = q & 15; *(LAS u32x4*)(lds + L_BI + row * RS_BC + c16 * 16) = st[2 + r]; }
#pragma unroll
        for (int r = 0; r < 4; ++r) { const int q = tid + 512 * r, row = q >> 4, c16 = q & 15; *(LAS u32x4*)(lds + L_CI + row * RS_BC + c16 * 16) = st[6 + r]; }
#pragma unroll
        for (int pt = 0; pt < 4; ++pt) { u32x2 w; w.x = pk2(hacc[pt][0], hacc[pt][1]); w.y = pk2(hacc[pt][2], hacc[pt][3]);
            *(LAS u32x2*)(lds + L_HI + lcol * RS_X + (16 * pt + 4 * g) * 2) = w; }
        u32x2 ycur[4];
#pragma unroll
        for (int pt = 0; pt < 4; ++pt) ycur[pt] = yprev[pt];
        if (step + 1 < nc) SSD_LOAD_CHUNK(BWD ? c - 1 : c + 1);
        __syncthreads();
        {
            const float csl = *(LAS float*)(lds + csb + lcol * 4);
            bf16x8 cf[4];
#pragma unroll
            for (int k = 0; k < 4; ++k) cf[k] = *(LAS bf16x8*)(lds + L_CI + lcol * RS_BC + (32 * k + 8 * g) * 2);
            f32x4 yacc[4];
#pragma unroll
            for (int pt = 0; pt < 4; ++pt) yacc[pt] = (f32x4){0.f, 0.f, 0.f, 0.f};
            bf16x8 hf[2][4];
#define SSD_LD_H(buf_, k_) do { _Pragma("unroll") for (int pt = 0; pt < 4; ++pt) { LAS unsigned char* p0 = lds + L_HI + (32 * (k_) + 8 * g + q4) * RS_X + (16 * pt) * 2 + 8 * pp; \
                hf[buf_][pt] = cat4(trd(p0), trd(p0 + 4 * RS_X)); } } while (0)
            SSD_LD_H(0, 0);
            SSD_SB();
#pragma unroll
            for (int k = 0; k < 4; ++k) {
                if (k < 3) SSD_LD_H((k + 1) & 1, k + 1);
#pragma unroll
                for (int pt = 0; pt < 4; ++pt) yacc[pt] = MFMA16(hf[k & 1][pt], cf[k], yacc[pt]);
                SSD_SB();
            }
            const float el = fexp(csl);
#pragma unroll
            for (int pt = 0; pt < 4; ++pt) yacc[pt] *= el;
#pragma unroll 1
            for (int sb = 0; sb < 4; ++sb) {
                const bool need = BWD ? (2 * sb + 1 >= wave) : (2 * sb <= wave);
                if (!need) continue;
                bf16x8 ba[2][4]; f32x4 css[2], dtv[2]; bf16x8 xa[4];
#pragma unroll
                for (int u = 0; u < 2; ++u) {
#pragma unroll
                    for (int k = 0; k < 4; ++k) ba[u][k] = *(LAS bf16x8*)(lds + L_BI + (32 * sb + 16 * u + cl) * RS_BC + (32 * k + 8 * g) * 2);
                    css[u] = *(LAS f32x4*)(lds + csb + (32 * sb + 16 * u + 4 * g) * 4); dtv[u] = *(LAS f32x4*)(lds + csb + 512 + (32 * sb + 16 * u + 4 * g) * 4); }
#pragma unroll
                for (int pt = 0; pt < 4; ++pt) { LAS unsigned char* p0 = lds + L_XI + (32 * sb + 4 * g + q4) * RS_X + (16 * pt) * 2 + 8 * pp; xa[pt] = cat4(trd(p0), trd(p0 + 16 * RS_X)); }
                SSD_SB();
                f32x4 sacc[2] = {(f32x4){0.f, 0.f, 0.f, 0.f}, (f32x4){0.f, 0.f, 0.f, 0.f}};
#pragma unroll
                for (int k = 0; k < 4; ++k) { sacc[0] = MFMA16(ba[0][k], cf[k], sacc[0]); sacc[1] = MFMA16(ba[1][k], cf[k], sacc[1]); }
                f32x4 m[2];
#pragma unroll
                for (int u = 0; u < 2; ++u)
#pragma unroll
                    for (int j = 0; j < 4; ++j) { const int s = 32 * sb + 16 * u + 4 * g + j; const bool valid = BWD ? (s >= lcol) : (s <= lcol);
                        float v = valid ? sacc[u][j] * fexp(fminf(csl - css[u][j], 0.f)) * dtv[u][j] : 0.f;
                        if (!BWD && s == lcol) v += dskip;
                        m[u][j] = v; }
                u32x4 mw; mw.x = pk2(m[0][0], m[0][1]); mw.y = pk2(m[0][2], m[0][3]); mw.z = pk2(m[1][0], m[1][1]); mw.w = pk2(m[1][2], m[1][3]);
                const bf16x8 mf = __builtin_bit_cast(bf16x8, mw);
#pragma unroll
                for (int pt = 0; pt < 4; ++pt) yacc[pt] = MFMA16(xa[pt], mf, yacc[pt]);
                SSD_SB();
            }
            bf16* yp = YH + (size_t)(tokc + lcol) * DIN + h * 64 + 4 * g;
#pragma unroll
            for (int pt = 0; pt < 4; ++pt) { f32x4 v = yacc[pt];
                if (!BWD) { v[0] += blo(ycur[pt].x); v[1] += bhi(ycur[pt].x); v[2] += blo(ycur[pt].y); v[3] += bhi(ycur[pt].y); }
                u32x2 w; w.x = pk2(v[0], v[1]); w.y = pk2(v[2], v[3]); *(u32x2*)(yp + 16 * pt) = w; }
            const float dec = fexp(*(LAS float*)(lds + csb + 1536));
#pragma unroll
            for (int pt = 0; pt < 4; ++pt) hacc[pt] *= dec;
            s16x4 sb0[2], sb1[2]; f32x4 sw0[2], sw1[2]; bf16x8 sx[2][4];
#define SSD_LD_S(buf_, k_) do { LAS unsigned char* pb = lds + L_BI + (32 * (k_) + 8 * g + q4) * RS_BC + (16 * wave) * 2 + 8 * pp; \
                sb0[buf_] = trd(pb); sb1[buf_] = trd(pb + 4 * RS_BC); \
                sw0[buf_] = *(LAS f32x4*)(lds + csb + 1024 + (32 * (k_) + 8 * g) * 4); sw1[buf_] = *(LAS f32x4*)(lds + csb + 1024 + (32 * (k_) + 8 * g + 4) * 4); \
                _Pragma("unroll") for (int pt = 0; pt < 4; ++pt) { LAS unsigned char* p0 = lds + L_XI + (32 * (k_) + 8 * g + q4) * RS_X + (16 * pt) * 2 + 8 * pp; sx[buf_][pt] = cat4(trd(p0), trd(p0 + 4 * RS_X)); } } while (0)
            SSD_LD_S(0, 0);
            SSD_SB();
#pragma unroll
            for (int k = 0; k < 4; ++k) {
                if (k < 3) SSD_LD_S((k + 1) & 1, k + 1);
                const s16x4 b0 = sb0[k & 1], b1 = sb1[k & 1]; const f32x4 w0 = sw0[k & 1], w1 = sw1[k & 1];
                u32x4 bw;
                bw.x = pk2(__uint_as_float((unsigned)(unsigned short)b0[0] << 16) * w0[0], __uint_as_float((unsigned)(unsigned short)b0[1] << 16) * w0[1]);
                bw.y = pk2(__uint_as_float((unsigned)(unsigned short)b0[2] << 16) * w0[2], __uint_as_float((unsigned)(unsigned short)b0[3] << 16) * w0[3]);
                bw.z = pk2(__uint_as_float((unsigned)(unsigned short)b1[0] << 16) * w1[0], __uint_as_float((unsigned)(unsigned short)b1[1] << 16) * w1[1]);
                bw.w = pk2(__uint_as_float((unsigned)(unsigned short)b1[2] << 16) * w1[2], __uint_as_float((unsigned)(unsigned short)b1[3] << 16) * w1[3]);
                const bf16x8 bfr = __builtin_bit_cast(bf16x8, bw);
#pragma unroll
                for (int pt = 0; pt < 4; ++pt) hacc[pt] = MFMA16(sx[k & 1][pt], bfr, hacc[pt]);
                SSD_SB();
            }
            if (step + 1 < nc) SSD_SCAN(L_CS + ((step + 1) & 1) * 2048);
        }
        __syncthreads();
    }
#undef SSD_LD_H
#undef SSD_LD_S
#undef SSD_SCAN
#undef SSD_LOAD_CHUNK
#undef SSD_SB
    if (hout) {
#pragma unroll
        for (int pt = 0; pt < 4; ++pt)
#pragma unroll
            for (int j = 0; j < 4; ++j) hout[(size_t)(16 * pt + 4 * g + j) * 128 + lcol] = hacc[pt][j];
    }
}
__device__ __forceinline__ void ssd_phase(const Args& a, int l, LAS unsigned char* lds, int vcu, int G, int tid, int wave, int lane) {
    unsigned char* wsb = a.ws; asm volatile("" : "+s"(wsb));
    { unsigned z_ = 0; asm volatile("" : "+s"(z_)); lds += z_; }
    const bf16* XH = (const bf16*)(wsb + WS_RA + RA_XH); const bf16* BG = (const bf16*)(wsb + WS_RA + RA_BG); const bf16* CG = (const bf16*)(wsb + WS_RA + RA_CG);
    const float* DT = (const float*)(wsb + WS_DT); bf16* YH = (bf16*)(wsb + WS_RB);
    for (int item = vcu; item < 256 + 512; item += G) {
        int tok0, nc, h; const float *h0f = nullptr, *h0b = nullptr; float *hof = nullptr, *hob = nullptr;
        if (item < 256) { const int b = item >> 5; h = item & 31; tok0 = T_CTX + b * 4096; nc = 32;
            h0f = a.in[2] + ((size_t)(b * 2 + l) * 32 + h) * 8192; h0b = a.in[3] + ((size_t)(b * 2 + l) * 32 + h) * 8192; }
        else { const int i2 = item - 256, b = i2 >> 5; h = i2 & 31; tok0 = b * 256; nc = 2;
            hof = a.out + OUT_SF + ((size_t)(b * 2 + l) * 32 + h) * 8192; hob = a.out + OUT_SB + ((size_t)(b * 2 + l) * 32 + h) * 8192; }
        const float af = -fexp(a.in[18][(size_t)l * 64 + h]), ab = -fexp(a.in[18][(size_t)l * 64 + 32 + h]);
        const float dsk = a.in[20][(size_t)l * 32 + h];
        ssd_sweep<true>(lds, XH, BG, CG, DT, YH, tok0, nc, h, ab, dsk, h0b, hob, tid, wave, lane);
        ssd_sweep<false>(lds, XH, BG, CG, DT, YH, tok0, nc, h, af, dsk, h0f, hof, tid, wave, lane);
    }
}

#define XB_TMO      128
#define XB_XCNT(j)  (256  + 64 * (j))
#define XB_XSUB(j)  (1280 + 64 * (j))
#define XB_XGEN(j)  (2304 + 64 * (j))
#define XB_TOP      3328
#define XB_TOPGEN   3392
#define XCD_BAR_WORDS 3456
#define XB_SPIN_CAP (1u << 18)

__device__ __forceinline__ unsigned xb_ld(unsigned* p)              { return __hip_atomic_load(p, __ATOMIC_RELAXED, __HIP_MEMORY_SCOPE_AGENT); }
__device__ __forceinline__ unsigned xb_add(unsigned* p, unsigned v) { return __hip_atomic_fetch_add(p, v, __ATOMIC_RELAXED, __HIP_MEMORY_SCOPE_AGENT); }
__device__ __forceinline__ unsigned xb_xcc_id() { return (unsigned)__builtin_amdgcn_s_getreg((3 << 11) | 20) & 0xFu; }
#define XB_SPIN(cond, bar) do { unsigned _sp = 0; while (cond) { __builtin_amdgcn_s_sleep(1); \
    if ((++_sp & 255u) == 0u) { if (xb_ld(&(bar)[XB_TMO])) break; if (_sp > XB_SPIN_CAP) { atomicAdd(&(bar)[XB_TMO], 1u); break; } } } } while (0)

struct XcdBarrier {
    unsigned* bar; unsigned x;
    volatile LAS unsigned* st;
};

__device__ __forceinline__ XcdBarrier xcd_barrier_post(unsigned* bar, volatile LAS unsigned* st) {
    XcdBarrier b; b.bar = bar; b.x = xb_xcc_id(); b.st = st;
    if (threadIdx.x == 0) (void)xb_add(&bar[XB_XCNT(b.x)], 1u);
    return b;
}
__device__ __forceinline__ void xcd_barrier_complete(unsigned* bar, unsigned x, unsigned& nloc, unsigned& nx) {
    const unsigned G = gridDim.x * gridDim.y * gridDim.z;
    unsigned sum, cnt, mine, sp = 0u;
    for (;;) {
        sum = 0u; cnt = 0u; mine = 0u;
#pragma unroll 1
        for (unsigned j = 0; j < 16; ++j) { const unsigned c = xb_ld(&bar[XB_XCNT(j)]); sum += c; cnt += (c > 0u) ? 1u : 0u; }
        mine = xb_ld(&bar[XB_XCNT(x)]);
        if (sum == G) break;
        __builtin_amdgcn_s_sleep(1);
        if ((++sp & 255u) == 0u) { if (xb_ld(&bar[XB_TMO])) break; if (sp > XB_SPIN_CAP) { atomicAdd(&bar[XB_TMO], 1u); break; } }
    }
    nloc = mine > 0u ? mine : 1u; nx = cnt > 0u ? cnt : 1u;
}

__device__ __forceinline__ void xcd_barrier(const XcdBarrier& b) {
    asm volatile("s_waitcnt vmcnt(0)" ::: "memory");
    __syncthreads();
    if (threadIdx.x == 0) {
        unsigned* bar = b.bar;
        __builtin_amdgcn_s_waitcnt(0);
        unsigned nloc = b.st[0], nx = b.st[1];
        if (nloc == 0u) { xcd_barrier_complete(bar, b.x, nloc, nx); b.st[0] = nloc; b.st[1] = nx; }
        const unsigned old = xb_add(&bar[XB_XSUB(b.x)], 1u);
        const unsigned gen = old / nloc;
        if (old + 1u == (gen + 1u) * nloc) {
            __builtin_amdgcn_fence(__ATOMIC_RELEASE, "agent");
            asm volatile("s_waitcnt vmcnt(0)" ::: "memory");
            const unsigned og = xb_add(&bar[XB_TOP], 1u);
            const unsigned tg = og / nx;
            if (og + 1u == (tg + 1u) * nx) xb_add(&bar[XB_TOPGEN], 1u);
            else XB_SPIN(xb_ld(&bar[XB_TOPGEN]) == tg, bar);
            __builtin_amdgcn_fence(__ATOMIC_ACQUIRE, "agent");
            xb_add(&bar[XB_XGEN(b.x)], 1u);
            asm volatile("s_waitcnt vmcnt(0)" ::: "memory");
        } else {
            XB_SPIN(xb_ld(&bar[XB_XGEN(b.x)]) == gen, bar);
            __builtin_amdgcn_fence(__ATOMIC_ACQUIRE, "agent");
            asm volatile("s_waitcnt vmcnt(0)" ::: "memory");
        }
    }
    __syncthreads();
}

__global__ void __launch_bounds__(NTHR, 2) hybrid_fwd(Args a) {
    extern __shared__ __attribute__((aligned(16))) unsigned char lds_raw[];
    LAS unsigned char* lds = (LAS unsigned char*)lds_raw;
    cg::grid_group grid = cg::this_grid();
    constexpr int G = 256; const int bid = blockIdx.x;
    const int vcu = (G % 8 == 0) ? (bid % 8) * (G / 8) + bid / 8 : bid;
    const int ngw = G * NWAVES, ngt = G * NTHR;
#define TIDS() int tid = threadIdx.x; asm volatile("" : "+v"(tid)); const int lane = tid & 63, wave = __builtin_amdgcn_readfirstlane(tid >> 6); const int gw = vcu * NWAVES + wave, gt = bid * NTHR + tid; (void)lane; (void)gw; (void)gt;
    unsigned char* ws = a.ws; unsigned char* wb = ws + WS_W;
    float* X = a.out; const float* MODB = (const float*)(ws + WS_MOD);
    const bf16* H = (const bf16*)(ws + WS_H);

    if (threadIdx.x < 64) ((LAS unsigned*)(lds + 131072))[threadIdx.x] = 0u;
    __syncthreads();
    XcdBarrier xbar = xcd_barrier_post((unsigned*)(ws + WS_BAR), (volatile LAS unsigned*)(lds + 131072));
#define GSYNC() xcd_barrier(xbar)
    constexpr bool split2 = true;
#define OPQ_S(v) asm volatile("" : "+s"(v))
#define PHV() int bid = blockIdx.x; OPQ_S(bid); unsigned char* ws = a.ws; OPQ_S(ws); unsigned char* wb = ws + WS_W; const bf16* H = (const bf16*)(ws + WS_H); float* X = a.out; (void)bid; (void)wb; (void)H; (void)X;
    { TIDS(); adaln_phase(a, lds, tid);
    __syncthreads();
    convert_phase(a, 0, lds, gw, ngw, wave, lane); }
    grid.sync();
#pragma unroll 1
    for (int l = 0; l < 2; ++l) {
        const float* mod = MODB + (size_t)l * 9 * 9216;
        if (l == 1) { TIDS(); convert_phase(a, 1, lds, gw, ngw, wave, lane); }
#pragma unroll 1
        for (int f = 0; f < 2; ++f) {
            if (f == 1) {
                { TIDS(); normmod_phase(a, l, 1, false, split2, gw, ngw, lane);
                  float* rss = (float*)(a.ws + WS_ROWSS); for (int i = gt; i < T_ALL; i += ngt) rss[i] = 0.f; }
                GSYNC();
#pragma unroll 1
                for (int hs = 0; hs < 2; ++hs) {
                    const int npc = hs ? 2 : 1;
#pragma unroll 1
                    for (int pc = 0; pc < npc; ++pc) {
                        const int tb = hs ? (pc ? 0 : 16384) : 1280, tcnt = hs ? (pc ? 1280 : 20480) : 15104, ro = (hs && !pc) ? 1280 : 0;
                        PHV(); const int cc = (hs && pc) ? ((bid >= 128 && bid < 193) ? bid - 128 : (1 << 20)) : bid;
                        pg8::Gemm g{H + (size_t)tb * DM, (const bf16*)(wb + WO_WINA), tcnt, NA_ROWS, DM, DM, DM, 0}; pg8::StaticOrder S; S.init(tcnt, NA_ROWS, G, cc);
                        pg8::EpiStore E{(bf16*)(ws + WS_RB) + (size_t)ro * CONVD, CONVD, 12, (float*)(ws + WS_DT) + (size_t)tb * 64, a.in[19] + (size_t)l * 64, 0, 0};
                        pg8::gemm_phase<pg8::EpiStore, pg8::StaticOrder>(lds, g, S, E);
                    }
                    GSYNC();
#pragma unroll 1
                    for (int pc = 0; pc < npc; ++pc) {
                        const int tb = hs ? (pc ? 0 : 16384) : 1280, tcnt = hs ? (pc ? 1280 : 20480) : 15104, ro = (hs && !pc) ? 1280 : 0;
                        TIDS(); conv_phase(a, l, tb, tcnt, ro, gw, ngw, lane);
                    }
                    GSYNC();
                }
                { TIDS(); ssd_phase(a, l, lds, vcu, G, tid, wave, lane); }
                GSYNC();
                { PHV(); pg8::Gemm g{H, (const bf16*)(wb + WO_WINB), T_ALL, DIN, DM, DM, DM, 0}; pg8::StaticOrder S; S.init(T_ALL, DIN, G, bid);
                  pg8::EpiYZ E{(bf16*)(ws + WS_RB), DIN, (float*)(ws + WS_ROWSS)};
                  pg8::gemm_phase<pg8::EpiYZ, pg8::StaticOrder>(lds, g, S, E); }
                GSYNC();
                { PHV(); pg8::Gemm g{H, (const bf16*)(wb + WO_WINB) + (size_t)DIN * DM, T_ALL, 3 * DM, DM, DM, DM, 0}; pg8::StaticOrder S; S.init(T_ALL, 3 * DM, G, bid);
                  pg8::EpiStore E{(bf16*)(ws + WS_RA + RA_U), DM, -1, nullptr, nullptr, 4, (size_t)T_ALL * DM};
                  pg8::gemm_phase<pg8::EpiStore, pg8::StaticOrder>(lds, g, S, E); }
                GSYNC();
                { TIDS(); hpool_phase(a, gt, ngt); }
                GSYNC();
                { TIDS(); vpool_phase(a, gt, ngt); }
                GSYNC();
                { PHV(); pg8::Gemm g{(const bf16*)(ws + WS_RB), (const bf16*)(wb + WO_WBS), T_ALL, DM, DIN, DIN, DIN, 0}; pg8::StaticOrder S; S.init(T_ALL, DM, G, bid);
                  pg8::EpiGate<3> E{(bf16*)(ws + WS_RA + RA_GB), DM, nullptr, (const bf16*)(ws + WS_RA + RA_GB), DM, (const float*)(ws + WS_ROWSS)};
                  pg8::gemm_phase<pg8::EpiGate<3>, pg8::StaticOrder>(lds, g, S, E); }
                { PHV(); const int nl = G / 4; pg8::Gemm g{(const bf16*)(ws + WS_RA + RA_U), (const bf16*)(wb + WO_PW), T_ALL, DM, 256, DM, 256, 512}; pg8::StaticOrder S; S.init(T_ALL, DM, G - nl, bid >= nl ? bid - nl : (1 << 20));
                  pg8::EpiGate<0> E{(bf16*)(ws + WS_H), DM, a.in[15] + (size_t)l * DM, nullptr, 0, nullptr};
                  pg8::gemm_phase<pg8::EpiGate<0>, pg8::StaticOrder>(lds, g, S, E); }
                GSYNC();
                { PHV(); pg8::Gemm g{H, (const bf16*)(wb + WO_WBP), T_ALL, DM, DM, DM, DM, 0}; pg8::StaticOrder S; S.init(T_ALL, DM, G, bid);
                  pg8::EpiGate<2> E{(bf16*)(ws + WS_RA + RA_GB), DM, nullptr, (const bf16*)(ws + WS_RA + RA_GA), DM, nullptr};
                  pg8::gemm_phase<pg8::EpiGate<2>, pg8::StaticOrder>(lds, g, S, E); }
                GSYNC();
                { PHV(); pg8::Gemm g{(const bf16*)(ws + WS_RA + RA_GB), (const bf16*)(wb + WO_WO), T_ALL, DM, DM, DM, DM, 0}; pg8::StaticOrder S; S.init(T_ALL, DM, G, bid);
                  pg8::EpiResid E{(const bf16*)X, (bf16*)X, a.in[0], a.in[1], mod, 5 * DM, 1.0f, 0, 0};
                  pg8::gemm_phase<pg8::EpiResid, pg8::StaticOrder>(lds, g, S, E); }
                GSYNC();
            }
            const bool use_in = (l == 0 && f == 0);
            { TIDS(); normmod_phase(a, l, f ? 2 : 0, use_in, split2 && f == 0 && l == 1, gw, ngw, lane); }
            GSYNC();
            { PHV(); pg8::Gemm g{H, (const bf16*)(wb + (f ? WO_W13B : WO_W13A)), T_ALL, 2 * DFF, DM, DM, DM, 0}; pg8::StaticOrder S; S.init(T_ALL, 2 * DFF, G, bid);
              pg8::EpiSwiGLU E{(bf16*)(ws + WS_RA), DFF};
              pg8::gemm_phase<pg8::EpiSwiGLU, pg8::StaticOrder>(lds, g, S, E); }
            GSYNC();
            {
              { PHV(); pg8::Gemm g{(const bf16*)(ws + WS_RA), (const bf16*)(wb + (f ? WO_W2B : WO_W2A)), T_ALL, DM, DFF, DFF, DFF, 0}; pg8::PanelOrder S{0, bid};
                pg8::EpiResid E{(const bf16*)X, (l == 1 && f == 1) ? (bf16*)(ws + WS_RB) : (bf16*)X, a.in[0], a.in[1], mod, (f ? 8 : 2) * DM, 0.5f, 0, use_in ? 1 : 0};
                pg8::gemm_phase<pg8::EpiResid, pg8::PanelOrder>(lds, g, S, E); }
              { PHV(); pg8::Gemm g{(const bf16*)(ws + WS_RA), (const bf16*)(wb + (f ? WO_W2B : WO_W2A)), T_ALL, DM, DFF / 2, DFF, DFF, 0}; pg8::PanelOrder S{1, bid};
                pg8::EpiResid E{(const bf16*)X, (l == 1 && f == 1) ? (bf16*)(ws + WS_RB) : (bf16*)X, a.in[0], a.in[1], mod, (f ? 8 : 2) * DM, 0.5f, 0, use_in ? 1 : 0};
                pg8::gemm_phase<pg8::EpiResid, pg8::PanelOrder>(lds, g, S, E); }
              { PHV(); pg8::Gemm g{(const bf16*)(ws + WS_RA) + DFF / 2, (const bf16*)(wb + (f ? WO_W2B : WO_W2A)) + DFF / 2, T_ALL, DM, DFF / 2, DFF, DFF, 0}; pg8::PanelOrder S{1, bid - 64};
                pg8::EpiDelta E{(bf16*)(ws + WS_D2), mod, (f ? 8 : 2) * DM, 0.5f};
                pg8::gemm_phase<pg8::EpiDelta, pg8::PanelOrder>(lds, g, S, E); }
            }
            GSYNC();
        }
    }
    { TIDS(); final_norm_phase(a, split2, gw, ngw, lane); }
}

extern "C" void kernel_launch(void* const* d_in, const int* in_sizes, int n_in, void* d_out, int out_size, void* d_ws, size_t ws_size, hipStream_t stream) {
    static int grid = 0;
    if (grid == 0) {
        if (n_in != 26 || ws_size < WS_END) { fprintf(stderr, "kernel_launch: unexpected n_in %d / ws_size %zu\n", n_in, ws_size); grid = -1; return; }
        int dev = 0, cus = 0, per_cu = 0;
        hipGetDevice(&dev);
        hipDeviceGetAttribute(&cus, hipDeviceAttributeMultiprocessorCount, dev);
        if (hipFuncSetAttribute((const void*)hybrid_fwd, hipFuncAttributeMaxDynamicSharedMemorySize, LDS_BYTES) != hipSuccess) { fprintf(stderr, "kernel_launch: hipFuncSetAttribute failed\n"); }
        if (hipOccupancyMaxActiveBlocksPerMultiprocessor(&per_cu, (const void*)hybrid_fwd, NTHR, LDS_BYTES) != hipSuccess || per_cu < 1) { fprintf(stderr, "kernel_launch: occupancy query gave %d\n", per_cu); per_cu = 1; }
        (void)hipGetLastError();
        grid = cus;
        if (grid != 256) { fprintf(stderr, "kernel_launch: built for a 256-CU device (got %d); nothing launched\n", grid); grid = -1; return; }
    }
    if (grid < 0) return;
    Args a{};
    for (int i = 0; i < 26; ++i) a.in[i] = (const float*)d_in[i];
    a.out = (float*)d_out; a.ws = (unsigned char*)d_ws;
    if (hipMemsetAsync((char*)d_ws + WS_BAR, 0, BAR_ZERO_BYTES, stream) != hipSuccess) { fprintf(stderr, "kernel_launch: memset failed\n"); return; }
    void* args[] = {&a};
    hipError_t e = hipLaunchCooperativeKernel((const void*)hybrid_fwd, dim3(grid), dim3(NTHR), args, LDS_BYTES, stream);
    if (e != hipSuccess) fprintf(stderr, "cooperative launch failed: %s (grid %d)\n", hipGetErrorString(e), grid);
}
```

```cpp
#include <hip/hip_runtime.h>
#include <hip/hip_cooperative_groups.h>
#include <cstdio>
#include <cstdint>
namespace pg8 {
#define PG8_LAS __attribute__((address_space(3)))
typedef unsigned short bf16_t;
typedef short bf16x8 __attribute__((ext_vector_type(8)));
typedef float f32x4 __attribute__((ext_vector_type(4)));
typedef unsigned u32x4 __attribute__((ext_vector_type(4)));
constexpr int BM = 256, BK = 64, HALF = 128, HTB = HALF * BK * 2  , STAGE_BYTES = 8 * HTB, NXCD = 8, WGM = 8;

__host__ __device__ __forceinline__ int lds_byte(int r, int c) { const int st = (r >> 4) * 2 + (c >> 5), rr = r & 15, cc = c & 31, ob = rr * 64 + cc * 2; return st * 1024 + (ob ^ (((ob >> 9) & 1) << 5)); }
__host__ __device__ __forceinline__ void stage_rc(int b, int& R, int& C) { const int st = b / 1024, sb = b % 1024, swz = sb ^ (((sb >> 9) & 1) << 5); R = (st >> 1) * 16 + swz / 64; C = (st & 1) * 32 + (swz % 64) / 2; }
__host__ __device__ __forceinline__ int perm32(int rho) { const int n = rho >> 4, i = rho & 15; return 8 * (i >> 2) + 4 * n + (i & 3); }

__device__ __forceinline__ float fexp(float x) { return __builtin_amdgcn_exp2f(x * 1.4426950408889634f); }
struct Unit { int pm, pn; };
struct Gemm { const bf16_t* A; const bf16_t* Bt; int M, N, K, lda, ldb, a_pn_bytes; };

struct StaticOrder {
    int nM, nN, nwg, G, c;
    __host__ __device__ void init(int M, int N, int G_, int c_) { nM = M / BM; nN = N / BM; nwg = nM * nN; G = G_; c = c_; }
    __host__ __device__ bool next(int i, Unit& u) const {
        const int L = i * G + c; if (L >= nwg) return false;
        int wgid = L; { const int q = nwg / NXCD, r = nwg % NXCD, xcd = wgid % NXCD, off = wgid / NXCD; wgid = (xcd < r ? xcd * (q + 1) : r * (q + 1) + (xcd - r) * q) + off; }
        const int nig = WGM * nN, gid = wgid / nig, fm = gid * WGM, gsz = (nM - fm) < WGM ? (nM - fm) : WGM;
        u.pm = fm + ((wgid % nig) % gsz); u.pn = (wgid % nig) / gsz; return true;
    }
    __device__ __forceinline__ void a_ready(const Unit&) const {}
    __device__ __forceinline__ void done(const Unit&) const {}
};

struct PanelOrder {
    int mode, c;
    __device__ __forceinline__ bool next(int i, Unit& u) const {
        const int xcd = c & 7, slot = c >> 3;
        if (mode == 0) { if (i >= 2) return false; u.pm = i * 64 + xcd * 8 + (slot >> 2); u.pn = slot & 3; return true; }
        if (i >= 1 || c < 0 || c >= 64) return false;
        u.pm = 128 + xcd * 2 + (slot >> 2); u.pn = slot & 3; return true;
    }
    __device__ __forceinline__ void a_ready(const Unit&) const {}
    __device__ __forceinline__ void done(const Unit&) const {}
};

__device__ __forceinline__ unsigned cvt_pk_bf16(float lo, float hi) { unsigned r; asm volatile("v_cvt_pk_bf16_f32 %0, %1, %2" : "=v"(r) : "v"(lo), "v"(hi)); return r; }

__device__ __forceinline__ float bf_lo(unsigned u) { return __uint_as_float(u << 16); }
__device__ __forceinline__ float bf_hi(unsigned u) { return __uint_as_float(u & 0xffff0000u); }
__device__ __forceinline__ float fsilu(float v) { return v * __builtin_amdgcn_rcpf(1.0f + fexp(-v)); }
__device__ __forceinline__ float fsigm(float v) { return __builtin_amdgcn_rcpf(1.0f + fexp(-v)); }
__device__ __forceinline__ float softplus_f(float x) { const float e = fexp(-fabsf(x)); const float l = e < 0.0078125f ? e * (1.0f + e * (-0.5f + e * 0.33333333f)) : (__builtin_amdgcn_logf(1.0f + e) * 0.69314718056f); return fmaxf(x, 0.f) + l; }

struct EpiSwiGLU {
    static constexpr bool PERM = true, AFTER_DRAIN = false;
    bf16_t* O; int ldc;
    __device__ __forceinline__ void operator()(const f32x4 (&acc)[2][2][4][2], const Unit& u, int wr, int wc, int fr, int fq) const {
        const int row0 = u.pm * BM + wr * 64 + fr, col0 = u.pn * HALF + wc * 32 + 8 * fq;
#pragma unroll
        for (int ai = 0; ai < 2; ++ai)
#pragma unroll
            for (int m = 0; m < 4; ++m) { bf16_t* rowp = O + (size_t)(row0 + ai * HALF + m * 16) * ldc + col0;
                float v[8];
#pragma unroll
                for (int n = 0; n < 2; ++n)
#pragma unroll
                    for (int i = 0; i < 4; ++i) v[n * 4 + i] = fsilu(acc[ai][0][m][n][i]) * acc[ai][1][m][n][i];
                u32x4 w; w.x = cvt_pk_bf16(v[0], v[1]); w.y = cvt_pk_bf16(v[2], v[3]); w.z = cvt_pk_bf16(v[4], v[5]); w.w = cvt_pk_bf16(v[6], v[7]);
                *(u32x4*)rowp = w; }
    }
};
struct EpiResid {
    static constexpr bool PERM = true, AFTER_DRAIN = false;
    const bf16_t* XB; bf16_t* XO; const float* xp; const float* xs; const float* mod; int gate_off; float scale; int pm0; int use_in;
    __device__ __forceinline__ void operator()(const f32x4 (&acc)[2][2][4][2], const Unit& u, int wr, int wc, int fr, int fq) const {
        const int pmg = u.pm + pm0;
        const int mrow = pmg < 16 ? 0 : 1 + ((pmg - 16) >> 4);
        const float* gate = mod + (size_t)mrow * 9216 + gate_off;
        const int col0 = u.pn * BM + wc * 32 + 8 * fq;
        const unsigned e0 = (unsigned)((wr * 64 + fr) * 1024 + col0);
        char* db = (char*)(XO + (size_t)pmg * 256 * 1024);
        if (use_in) {
            const char* sb = (const char*)(pmg < 16 ? xp + (size_t)pmg * 256 * 1024 : xs + (size_t)(pmg - 16) * 256 * 1024);
#pragma unroll
            for (int bj = 0; bj < 2; ++bj) {
                const f32x4 g0 = *(const f32x4*)(gate + col0 + bj * HALF) * scale, g1 = *(const f32x4*)(gate + col0 + bj * HALF + 4) * scale;
#pragma unroll
                for (int ai = 0; ai < 2; ++ai)
#pragma unroll
                  for (int mh = 0; mh < 4; mh += 2) {
                    f32x4 r0[2], r1[2];
                    unsigned eb = e0 + (unsigned)((ai * HALF + mh * 16) * 1024 + bj * HALF); asm volatile("" : "+v"(eb));
#pragma unroll
                    for (int m = 0; m < 2; ++m) { const unsigned e = eb + (unsigned)(m * 16 * 1024); r0[m] = *(const f32x4*)(sb + e * 4u); r1[m] = *(const f32x4*)(sb + e * 4u + 16u); }
#pragma unroll
                    for (int m = 0; m < 2; ++m) { const unsigned e = eb + (unsigned)(m * 16 * 1024);
                        const f32x4 v0 = r0[m] + g0 * acc[ai][bj][mh + m][0], v1 = r1[m] + g1 * acc[ai][bj][mh + m][1];
                        u32x4 w; w.x = cvt_pk_bf16(v0[0], v0[1]); w.y = cvt_pk_bf16(v0[2], v0[3]); w.z = cvt_pk_bf16(v1[0], v1[1]); w.w = cvt_pk_bf16(v1[2], v1[3]);
                        *(u32x4*)(db + e * 2u) = w; }
                    asm volatile("" ::: "memory");
                  }
            }
        } else {
            const char* sb = (const char*)(XB + (size_t)pmg * 256 * 1024);
#pragma unroll
            for (int bj = 0; bj < 2; ++bj) {
                const f32x4 g0 = *(const f32x4*)(gate + col0 + bj * HALF) * scale, g1 = *(const f32x4*)(gate + col0 + bj * HALF + 4) * scale;
                {
                    u32x4 r[2][4];
                    unsigned eb = e0 + (unsigned)(bj * HALF); asm volatile("" : "+v"(eb));
#pragma unroll
                    for (int ai = 0; ai < 2; ++ai)
#pragma unroll
                    for (int m = 0; m < 4; ++m) { const unsigned e = eb + (unsigned)((ai * HALF + m * 16) * 1024); r[ai][m] = *(const u32x4*)(sb + e * 2u); }
#pragma unroll
                    for (int ai = 0; ai < 2; ++ai)
#pragma unroll
                    for (int m = 0; m < 4; ++m) { const unsigned e = eb + (unsigned)((ai * HALF + m * 16) * 1024);
                        const u32x4 q = r[ai][m]; const f32x4 a0 = acc[ai][bj][m][0], a1 = acc[ai][bj][m][1];
                        u32x4 w;
                        w.x = cvt_pk_bf16(bf_lo(q.x) + g0[0] * a0[0], bf_hi(q.x) + g0[1] * a0[1]); w.y = cvt_pk_bf16(bf_lo(q.y) + g0[2] * a0[2], bf_hi(q.y) + g0[3] * a0[3]);
                        w.z = cvt_pk_bf16(bf_lo(q.z) + g1[0] * a1[0], bf_hi(q.z) + g1[1] * a1[1]); w.w = cvt_pk_bf16(bf_lo(q.w) + g1[2] * a1[2], bf_hi(q.w) + g1[3] * a1[3]);
                        *(u32x4*)(db + e * 2u) = w; }
                    asm volatile("" ::: "memory");
                }
            }
        }
    }
};
struct EpiDelta {
    static constexpr bool PERM = true, AFTER_DRAIN = false;
    bf16_t* D2; const float* mod; int gate_off; float scale;
    __device__ __forceinline__ void operator()(const f32x4 (&acc)[2][2][4][2], const Unit& u, int wr, int wc, int fr, int fq) const {
        const int mrow = u.pm < 16 ? 0 : 1 + ((u.pm - 16) >> 4);
        const float* gate = mod + (size_t)mrow * 9216 + gate_off;
        const int row0 = (u.pm - 128) * BM + wr * 64 + fr, col0 = u.pn * BM + wc * 32 + 8 * fq;
#pragma unroll
        for (int bj = 0; bj < 2; ++bj) {
            const f32x4 g0 = *(const f32x4*)(gate + col0 + bj * HALF) * scale, g1 = *(const f32x4*)(gate + col0 + bj * HALF + 4) * scale;
#pragma unroll
            for (int ai = 0; ai < 2; ++ai)
#pragma unroll
                for (int m = 0; m < 4; ++m) { const f32x4 v0 = acc[ai][bj][m][0] * g0, v1 = acc[ai][bj][m][1] * g1;
                    u32x4 w; w.x = cvt_pk_bf16(v0[0], v0[1]); w.y = cvt_pk_bf16(v0[2], v0[3]); w.z = cvt_pk_bf16(v1[0], v1[1]); w.w = cvt_pk_bf16(v1[2], v1[3]);
                    *(u32x4*)(D2 + (size_t)(row0 + ai * HALF + m * 16) * 1024 + col0 + bj * HALF) = w; }
        }
    }
};
struct EpiYZ {
    static constexpr bool PERM = true, AFTER_DRAIN = false;
    bf16_t* Y; int ldc; float* rowss;
    __device__ __forceinline__ void operator()(const f32x4 (&acc)[2][2][4][2], const Unit& u, int wr, int wc, int fr, int fq) const {
        const int row0 = u.pm * BM + wr * 64 + fr, col0 = u.pn * BM + wc * 32 + 8 * fq;
#pragma unroll
        for (int ai = 0; ai < 2; ++ai) {
            float ss[4] = {0.f, 0.f, 0.f, 0.f};
            unsigned eb = (unsigned)((row0 + ai * HALF) * ldc + col0); asm volatile("" : "+v"(eb));
            u32x4 yq[2][4];
#pragma unroll
            for (int bj = 0; bj < 2; ++bj)
#pragma unroll
                for (int m = 0; m < 4; ++m) yq[bj][m] = *(const u32x4*)((const char*)Y + ((size_t)eb + (size_t)(m * 16 * ldc + bj * HALF)) * 2u);
#pragma unroll
            for (int bj = 0; bj < 2; ++bj) {
#pragma unroll
                for (int m = 0; m < 4; ++m) { const f32x4 a0 = acc[ai][bj][m][0], a1 = acc[ai][bj][m][1]; const u32x4 q = yq[bj][m];
                    const float v0 = bf_lo(q.x) * fsilu(a0[0]), v1 = bf_hi(q.x) * fsilu(a0[1]), v2 = bf_lo(q.y) * fsilu(a0[2]), v3 = bf_hi(q.y) * fsilu(a0[3]);
                    const float v4 = bf_lo(q.z) * fsilu(a1[0]), v5 = bf_hi(q.z) * fsilu(a1[1]), v6 = bf_lo(q.w) * fsilu(a1[2]), v7 = bf_hi(q.w) * fsilu(a1[3]);
                    ss[m] += (v0 * v0 + v1 * v1) + (v2 * v2 + v3 * v3) + (v4 * v4 + v5 * v5) + (v6 * v6 + v7 * v7);
                    u32x4 w; w.x = cvt_pk_bf16(v0, v1); w.y = cvt_pk_bf16(v2, v3); w.z = cvt_pk_bf16(v4, v5); w.w = cvt_pk_bf16(v6, v7);
                    *(u32x4*)((char*)Y + ((size_t)eb + (size_t)(m * 16 * ldc + bj * HALF)) * 2u) = w; }
                asm volatile("" ::: "memory");
            }
#pragma unroll
            for (int m = 0; m < 4; ++m) { float s = ss[m]; s += __shfl_xor(s, 16); s += __shfl_xor(s, 32);
                if (fq == 0) atomicAdd(rowss + row0 + ai * HALF + m * 16, s); }
        }
    }
};
struct EpiStore {
    static constexpr bool PERM = true, AFTER_DRAIN = false;
    bf16_t* O; int ldc; int dt_pn; float* DT; const float* dtb; int split_pn; size_t split_stride;
    __device__ __forceinline__ void operator()(const f32x4 (&acc)[2][2][4][2], const Unit& u, int wr, int wc, int fr, int fq) const {
        const int row0 = u.pm * BM + wr * 64 + fr;
        if (u.pn == dt_pn) {
            if (wc < 2) {
                const int c0 = wc * 32 + 8 * fq;
                f32x4 b0 = *(const f32x4*)(dtb + c0), b1 = *(const f32x4*)(dtb + c0 + 4);
#pragma unroll
                for (int ai = 0; ai < 2; ++ai)
#pragma unroll
                    for (int m = 0; m < 4; ++m) { float* rowp = DT + (size_t)(row0 + ai * HALF + m * 16) * 64 + c0;
                        f32x4 v0 = acc[ai][0][m][0] + b0, v1 = acc[ai][0][m][1] + b1;
#pragma unroll
                        for (int i = 0; i < 4; ++i) { v0[i] = softplus_f(v0[i]); v1[i] = softplus_f(v1[i]); }
                        *(f32x4*)rowp = v0; *(f32x4*)(rowp + 4) = v1; }
            }
            return;
        }
        int pnl = u.pn; bf16_t* base = O;
        if (split_pn > 0) { const int t = u.pn / split_pn; pnl = u.pn - t * split_pn; base = O + (size_t)t * split_stride; }
        const int col0 = pnl * BM + wc * 32 + 8 * fq;
#pragma unroll
        for (int ai = 0; ai < 2; ++ai)
#pragma unroll
            for (int m = 0; m < 4; ++m) { bf16_t* rowp = base + (size_t)(row0 + ai * HALF + m * 16) * ldc + col0;
#pragma unroll
                for (int bj = 0; bj < 2; ++bj) { const f32x4 v0 = acc[ai][bj][m][0], v1 = acc[ai][bj][m][1];
                    u32x4 w; w.x = cvt_pk_bf16(v0[0], v0[1]); w.y = cvt_pk_bf16(v0[2], v0[3]); w.z = cvt_pk_bf16(v1[0], v1[1]); w.w = cvt_pk_bf16(v1[2], v1[3]);
                    *(u32x4*)(rowp + bj * HALF) = w; } }
    }
};
template <int MODE> struct EpiGate {
    static constexpr bool PERM = true, AFTER_DRAIN = false;
    static constexpr int MB = 4;
    bf16_t* O; int ldc; const float* cs; const bf16_t* G; int ldg; const float* rowss;
    __device__ __forceinline__ void operator()(const f32x4 (&acc)[2][2][4][2], const Unit& u, int wr, int wc, int fr, int fq) const {
        const int row0 = u.pm * BM + wr * 64 + fr, col0 = u.pn * BM + wc * 32 + 8 * fq;
#pragma unroll
        for (int bj = 0; bj < 2; ++bj) {
            f32x4 s0 = (f32x4){1.f, 1.f, 1.f, 1.f}, s1 = s0;
            if (MODE == 0) { s0 = *(const f32x4*)(cs + col0 + bj * HALF); s1 = *(const f32x4*)(cs + col0 + bj * HALF + 4); }
#pragma unroll
            for (int ai = 0; ai < 2; ++ai)
#pragma unroll
              for (int mh = 0; mh < 4; mh += MB) {
                u32x4 gq[4], oq[4]; float rsv[4] = {1.f, 1.f, 1.f, 1.f};
                if (MODE != 0) {
#pragma unroll
                    for (int m = mh; m < mh + MB; ++m) { const int row = row0 + ai * HALF + m * 16;
                        if (MODE == 3) rsv[m] = rowss[row];
                        gq[m] = *(const u32x4*)(G + (size_t)row * ldg + col0 + bj * HALF);
                        if (MODE == 2) oq[m] = *(const u32x4*)(O + (size_t)row * ldc + col0 + bj * HALF); }
                }
#pragma unroll
                for (int m = mh; m < mh + MB; ++m) { const int row = row0 + ai * HALF + m * 16; bf16_t* rowp = O + (size_t)row * ldc + col0 + bj * HALF;
                    const f32x4 a0 = acc[ai][bj][m][0], a1 = acc[ai][bj][m][1];
                    float v[8] = {a0[0], a0[1], a0[2], a0[3], a1[0], a1[1], a1[2], a1[3]};
                    if (MODE == 0) {
#pragma unroll
                        for (int i = 0; i < 4; ++i) { v[i] *= s0[i]; v[4 + i] *= s1[i]; } }
                    else { const unsigned gw[4] = {gq[m].x, gq[m].y, gq[m].z, gq[m].w};
                        const float rr = (MODE == 3) ? __builtin_amdgcn_rsqf((rsv[m] + 2048.0f * 1e-6f) * (1.0f / 2048.0f)) : 1.0f;
#pragma unroll
                        for (int i = 0; i < 4; ++i) { v[2 * i] *= fsigm(bf_lo(gw[i])) * rr; v[2 * i + 1] *= fsigm(bf_hi(gw[i])) * rr; }
                        if (MODE == 2) { const unsigned ow[4] = {oq[m].x, oq[m].y, oq[m].z, oq[m].w};
#pragma unroll
                            for (int i = 0; i < 4; ++i) { v[2 * i] += bf_lo(ow[i]); v[2 * i + 1] += bf_hi(ow[i]); } } }
                    u32x4 w; w.x = cvt_pk_bf16(v[0], v[1]); w.y = cvt_pk_bf16(v[2], v[3]); w.z = cvt_pk_bf16(v[4], v[5]); w.w = cvt_pk_bf16(v[6], v[7]);
                    *(u32x4*)rowp = w; }
                asm volatile("" ::: "memory");
            }
        }
    }
};

template <class Epi, class Sched>
__device__ __forceinline__ void gemm_phase(PG8_LAS unsigned char* lds_in, const Gemm g, const Sched& S, const Epi& E) {
    PG8_LAS unsigned char* lds = lds_in; { unsigned z_ = 0; asm volatile("" : "+s"(z_)); lds += z_; }
    int tid_ = threadIdx.x; asm volatile("" : "+v"(tid_));
    const int tid = tid_, wid = __builtin_amdgcn_readfirstlane(tid >> 6), lane = tid & 63, wr = wid >> 2, wc = wid & 3, fr = lane & 15, fq = lane >> 4;
    const int K = g.K, nt = K / BK, lda = g.lda, ldb = g.ldb;
    unsigned voffA[2], voffB[2];
#pragma unroll
    for (int i = 0; i < 2; ++i) { int R, C; stage_rc(tid * 16 + i * 8192, R, C); const int Rb = Epi::PERM ? ((R & ~31) + perm32(R & 31)) : R;
        voffA[i] = (unsigned)(R * lda + C) * 2u; voffB[i] = (unsigned)(Rb * ldb + C) * 2u; }
    const size_t kstep = (size_t)(BK * 2);
    const size_t hstepA = (size_t)HALF * lda * 2, hstepB = (size_t)HALF * ldb * 2, acol = (size_t)g.a_pn_bytes;
    const size_t tstepA = 2 * hstepA, tstepB = 2 * hstepB;
    const unsigned ldsw = (unsigned)wid * 1024u;
    const int aoff = lds_byte(wr * 64 + fr, fq * 8), boff = lds_byte(wc * 32 + fr, fq * 8);
#define PG8_SA(b, h) (((b) * 2 + (h)) * HTB)
#define PG8_SB(b, h) ((4 + (b) * 2 + (h)) * HTB)
#define PG8_STAGE(bufoff, gbase, voff) do { _Pragma("unroll") for (int _i = 0; _i < 2; ++_i) \
        __builtin_amdgcn_global_load_lds((const unsigned*)((const char*)(gbase) + (voff)[_i]), (PG8_LAS unsigned*)(lds + (bufoff) + ldsw + _i * 8192), 16, 0, 0); } while (0)
#define PG8_LDA(dst, b, h) do { _Pragma("unroll") for (int m = 0; m < 4; ++m) _Pragma("unroll") for (int k = 0; k < 2; ++k) dst[m][k] = *(const PG8_LAS bf16x8*)(lds + PG8_SA(b, h) + aoff + m * 2048 + k * 1024); } while (0)
#define PG8_LDB(dst, b, h) do { _Pragma("unroll") for (int n = 0; n < 2; ++n) _Pragma("unroll") for (int k = 0; k < 2; ++k) dst[n][k] = *(const PG8_LAS bf16x8*)(lds + PG8_SB(b, h) + boff + n * 2048 + k * 1024); } while (0)
#define PG8_MMA(ai, bj, At, Bt) do { __builtin_amdgcn_s_setprio(1); _Pragma("unroll") for (int m = 0; m < 4; ++m) _Pragma("unroll") for (int n = 0; n < 2; ++n) _Pragma("unroll") for (int k = 0; k < 2; ++k) \
        acc[ai][bj][m][n] = __builtin_amdgcn_mfma_f32_16x16x32_bf16(Bt[n][k], At[m][k], acc[ai][bj][m][n], 0, 0, 0); __builtin_amdgcn_s_setprio(0); } while (0)
#define PG8_WAIT_V(n) asm volatile("s_waitcnt vmcnt(" #n ")" ::: "memory")
#define PG8_WAIT_L(n) asm volatile("s_waitcnt lgkmcnt(" #n ")" ::: "memory")
#define PG8_BAR __builtin_amdgcn_s_barrier()
#define PG8_SCHED __builtin_amdgcn_sched_barrier(0)
    Unit cur, nxt; int ui = 0;
    if (!S.next(0, cur)) return;
    f32x4 acc[2][2][4][2];
#pragma unroll
    for (int a = 0; a < 2; ++a)
#pragma unroll
        for (int b = 0; b < 2; ++b)
#pragma unroll
            for (int m = 0; m < 4; ++m)
#pragma unroll
                for (int n = 0; n < 2; ++n) acc[a][b][m][n] = (f32x4){0.f, 0.f, 0.f, 0.f};
    bf16x8 At[4][2], B0[2][2], B1[2][2];
    const char* cA = (const char*)g.A + (size_t)cur.pm * tstepA + (size_t)cur.pn * acol; const char* cB = (const char*)g.Bt + (size_t)cur.pn * tstepB;
    S.a_ready(cur);
    PG8_STAGE(PG8_SB(0, 0), cB, voffB); PG8_STAGE(PG8_SA(0, 0), cA, voffA); PG8_STAGE(PG8_SB(0, 1), cB + hstepB, voffB); PG8_STAGE(PG8_SA(0, 1), cA + hstepA, voffA);
    if (wr == 1) PG8_BAR;
    PG8_WAIT_V(4); PG8_BAR;
    PG8_STAGE(PG8_SB(1, 0), cB + kstep, voffB); PG8_STAGE(PG8_SA(1, 0), cA + kstep, voffA); PG8_STAGE(PG8_SB(1, 1), cB + hstepB + kstep, voffB);
    PG8_WAIT_V(6); PG8_BAR;
    for (;;) {
        const bool has_next = S.next(ui + 1, nxt);
        const char* nA = has_next ? (const char*)g.A + (size_t)nxt.pm * tstepA + (size_t)nxt.pn * acol : cA; const char* nB = has_next ? (const char*)g.Bt + (size_t)nxt.pn * tstepB : cB;
        for (int t = 0; t < nt; t += 2) {
            const bool last = (t == nt - 2);
            const char* a1 = cA + (size_t)(t + 1) * kstep;
            const char* a2 = last ? nA : cA + (size_t)(t + 2) * kstep; const char* b2 = last ? nB : cB + (size_t)(t + 2) * kstep;
            const char* a3 = a2 + kstep; const char* b3 = b2 + kstep;
            if (last && has_next) S.a_ready(nxt);
            PG8_LDB(B0, 0, 0); PG8_SCHED; PG8_LDA(At, 0, 0); PG8_STAGE(PG8_SA(1, 1), a1 + hstepA, voffA);
            PG8_WAIT_L(8); PG8_BAR; PG8_WAIT_L(0); PG8_MMA(0, 0, At, B0); PG8_BAR; PG8_SCHED;
            PG8_LDB(B1, 0, 1); PG8_STAGE(PG8_SB(0, 0), b2, voffB);
            PG8_BAR; PG8_WAIT_L(0); PG8_MMA(0, 1, At, B1); PG8_BAR;
            PG8_LDA(At, 0, 1); PG8_STAGE(PG8_SA(0, 0), a2, voffA);
            PG8_BAR; PG8_WAIT_L(0); PG8_MMA(1, 0, At, B0); PG8_BAR; PG8_SCHED;
            PG8_STAGE(PG8_SB(0, 1), b2 + hstepB, voffB);
            PG8_WAIT_V(6); PG8_BAR; PG8_MMA(1, 1, At, B1); PG8_BAR;
            PG8_LDB(B0, 1, 0); PG8_SCHED; PG8_LDA(At, 1, 0); PG8_STAGE(PG8_SA(0, 1), a2 + hstepA, voffA);
            PG8_WAIT_L(8); PG8_BAR; PG8_WAIT_L(0); PG8_MMA(0, 0, At, B0); PG8_BAR; PG8_SCHED;
            PG8_LDB(B1, 1, 1); PG8_STAGE(PG8_SB(1, 0), b3, voffB);
            PG8_BAR; PG8_WAIT_L(0); PG8_MMA(0, 1, At, B1); PG8_BAR;
            PG8_LDA(At, 1, 1); PG8_STAGE(PG8_SA(1, 0), a3, voffA);
            PG8_BAR; PG8_WAIT_L(0); PG8_MMA(1, 0, At, B0); PG8_BAR; PG8_SCHED;
            PG8_STAGE(PG8_SB(1, 1), b3 + hstepB, voffB);
            PG8_WAIT_V(6); PG8_BAR; PG8_MMA(1, 1, At, B1); PG8_BAR;
        }
        if constexpr (!Epi::AFTER_DRAIN) { E(acc, cur, wr, wc, fr, fq); S.done(cur); }
        if (!has_next) break;
#pragma unroll
        for (int a = 0; a < 2; ++a)
#pragma unroll
            for (int b = 0; b < 2; ++b)
#pragma unroll
                for (int m = 0; m < 4; ++m)
#pragma unroll
                    for (int n = 0; n < 2; ++n) acc[a][b][m][n] = (f32x4){0.f, 0.f, 0.f, 0.f};
        cur = nxt; cA = nA; cB = nB; ++ui;
    }
    PG8_WAIT_V(0);
    if (wr == 0) PG8_BAR;
    PG8_BAR;
    if constexpr (Epi::AFTER_DRAIN) { E.fused(acc, cur, wr, wc, fr, fq, lds, wid, lane); S.done(cur); }
#undef PG8_SA
#undef PG8_SB
#undef PG8_STAGE
#undef PG8_LDA
#undef PG8_LDB
#undef PG8_MMA
#undef PG8_WAIT_V
#undef PG8_WAIT_L
#undef PG8_BAR
#undef PG8_SCHED
}
}

namespace cg = cooperative_groups;
using pg8::fexp;
#define LAS __attribute__((address_space(3)))
typedef unsigned short bf16;
typedef short bf16x8 __attribute__((ext_vector_type(8)));
typedef short s16x4 __attribute__((ext_vector_type(4)));
typedef float f32x4 __attribute__((ext_vector_type(4)));
typedef unsigned u32x4 __attribute__((ext_vector_type(4)));
typedef unsigned u32x2 __attribute__((ext_vector_type(2)));

constexpr int DM = 1024, T_CTX = 4096, T_LAT = 32768, T_ALL = T_CTX + T_LAT, DFF = 2816, DIN = 2048, CONVD = 3072, NHEAD = 32;
constexpr int NWAVES = 8, NTHR = 512;
constexpr int LDS_BYTES = 131072 + 256;
constexpr size_t WS_BAR = 768 * 1024, BAR_ZERO_BYTES = 16384;
constexpr size_t WS_ROWSS = 800 * 1024;
constexpr float EPS = 1e-6f;
constexpr size_t MiB = 1u << 20;
constexpr size_t WS_MOD = 0;
constexpr size_t WS_W = 1 * MiB;
constexpr size_t WO_W13A = 0, WO_W2A = 11534336, WO_W13B = 17301504, WO_W2B = 28835840, WO_WINA = 34603008, WO_WINB = 41418752, WO_PW = 51904512, WO_WBP = 52428800, WO_WBS = 54525952, WO_WO = 58720256;
constexpr size_t WS_H = 60 * MiB, WS_RA = 132 * MiB, WS_RB = 348 * MiB, WS_DT = 492 * MiB, WS_D2 = 501 * MiB, WS_END = 509 * MiB;
constexpr int NA_ROWS = 3328, NB_ROWS = 5120;
constexpr size_t RA_Z = 0, RA_U = 0, RA_GA = 72 * MiB, RA_GB = 144 * MiB, RA_MG = RA_U;
constexpr size_t RA_XH = 0, RA_BG = (size_t)32 * 36864 * 64 * 2, RA_CG = RA_BG + (size_t)4 * 36864 * 128 * 2;
constexpr size_t OUT_SF = (size_t)T_ALL * DM, OUT_SB = OUT_SF + 16 * 2 * 32 * 64 * 128;

__device__ __forceinline__ unsigned f2bf(float f) { unsigned u = __float_as_uint(f); return (u + 0x7fffu + ((u >> 16) & 1u)) >> 16; }
__device__ __forceinline__ unsigned pk2(float lo, float hi) { return pg8::cvt_pk_bf16(lo, hi); }
__device__ __forceinline__ float blo(unsigned u) { return __uint_as_float(u << 16); }
__device__ __forceinline__ float bhi(unsigned u) { return __uint_as_float(u & 0xffff0000u); }
__device__ __forceinline__ float wave_sum(float v) {
#pragma unroll
    for (int o = 1; o < 64; o <<= 1) v += __shfl_xor(v, o);
    return v;
}
__device__ __forceinline__ float silu_f(float v) { return v * __builtin_amdgcn_rcpf(1.0f + fexp(-v)); }

struct Args {
    const float* in[26];
    float* out; unsigned char* ws;
};

__device__ __forceinline__ void transpose_item(const float* W, int ldw, int K, bf16* WT, int n0, int c0, int k0, LAS float* scr, int lane, const float* kscale = nullptr) {
    const int c = lane & 7;
    if (c0 < 0) {
#pragma unroll
        for (int j = 0; j < 4; ++j) { const int n = (lane >> 3) + 8 * j; *(u32x4*)(WT + (size_t)(n0 + n) * K + k0 + 8 * c) = (u32x4){0u, 0u, 0u, 0u}; }
        return;
    }
    float wv[32];
#pragma unroll
    for (int i = 0; i < 32; ++i) { const int kk = 2 * i + (lane >> 5); wv[i] = W[(size_t)(k0 + kk) * ldw + c0 + (lane & 31)]; if (kscale) wv[i] *= kscale[k0 + kk]; }
#pragma unroll
    for (int i = 0; i < 32; ++i) { const int kk = 2 * i + (lane >> 5); scr[kk * 33 + (lane & 31)] = wv[i]; }
    asm volatile("s_waitcnt lgkmcnt(0)" ::: "memory");
#pragma unroll
    for (int j = 0; j < 4; ++j) { const int n = (lane >> 3) + 8 * j; const LAS float* s = scr + (8 * c) * 33 + n;
        u32x4 o; o.x = pk2(s[0 * 33], s[1 * 33]); o.y = pk2(s[2 * 33], s[3 * 33]); o.z = pk2(s[4 * 33], s[5 * 33]); o.w = pk2(s[6 * 33], s[7 * 33]);
        *(u32x4*)(WT + (size_t)(n0 + n) * K + k0 + 8 * c) = o; }
    asm volatile("s_waitcnt lgkmcnt(0)" ::: "memory");
}
__device__ __forceinline__ void convert_phase(const Args& a, int l, LAS unsigned char* lds, int gw, int ngw, int wave, int lane) {
    unsigned char* wsb = a.ws; asm volatile("" : "+s"(wsb));
    { unsigned z_ = 0; asm volatile("" : "+s"(z_)); lds += z_; }
    LAS float* scr = (LAS float*)(lds + wave * 8448);
    unsigned char* wb = wsb + WS_W;
    constexpr int I13 = 16 * 176, I2 = 44 * 32, IA = 16 * 104, IB = 16 * 160, IPW = 128, IBP = 16 * 32, IBS = 32 * 32, IWO = 16 * 32;
    constexpr int NITEMS = 2 * I13 + 2 * I2 + IA + IB + IPW + IBP + IBS + IWO;
    for (int it = gw; it < NITEMS; it += ngw) {
        int r = it;
        if (r < 2 * I13) { const int which = r / I13; r -= which * I13; const int kb = r / 176, nb = r % 176, n0 = nb * 32, tile = n0 >> 8, j0 = n0 & 255;
            const int c0 = j0 < 128 ? 128 * tile + j0 : DFF + 128 * tile + (j0 - 128);
            transpose_item(a.in[which ? 11 : 9] + (size_t)l * DM * 2 * DFF, 2 * DFF, DM, (bf16*)(wb + (which ? WO_W13B : WO_W13A)), n0, c0, kb * 64, scr, lane); continue; }
        r -= 2 * I13;
        if (r < 2 * I2) { const int which = r / I2; r -= which * I2; const int kb = r / 32, nb = r % 32;
            transpose_item(a.in[which ? 12 : 10] + (size_t)l * DFF * DM, DM, DFF, (bf16*)(wb + (which ? WO_W2B : WO_W2A)), nb * 32, nb * 32, kb * 64, scr, lane); continue; }
        r -= 2 * I2;
        const float* win = a.in[13] + (size_t)l * DM * 8256;
        if (r < IA) { const int kb = r / 104, nb = r % 104, n0 = nb * 32; const int c0 = n0 < 3136 ? 3072 + n0 : -1;
            transpose_item(win, 8256, DM, (bf16*)(wb + WO_WINA), n0, c0, kb * 64, scr, lane); continue; }
        r -= IA;
        if (r < IB) { const int kb = r / 160, nb = r % 160, n0 = nb * 32; const int c0 = n0 < 2048 ? 1024 + n0 : (n0 < 3072 ? n0 - 2048 : n0 + 3136);
            transpose_item(win, 8256, DM, (bf16*)(wb + WO_WINB), n0, c0, kb * 64, scr, lane); continue; }
        r -= IB;
        if (r < IPW) { const int g = r / 32; r -= g * 32; const int kb = r / 8, nb = r % 8;
            transpose_item(a.in[14] + (size_t)(l * 4 + g) * 65536, 256, 256, (bf16*)(wb + WO_PW) + (size_t)g * 65536, nb * 32, nb * 32, kb * 64, scr, lane); continue; }
        r -= IPW;
        if (r < IBP) { const int kb = r / 32, nb = r % 32;
            transpose_item(a.in[22] + (size_t)l * DM * DM, DM, DM, (bf16*)(wb + WO_WBP), nb * 32, nb * 32, kb * 64, scr, lane); continue; }
        r -= IBP;
        if (r < IBS) { const int kb = r / 32, nb = r % 32;
            transpose_item(a.in[23] + (size_t)l * DIN * DM, DM, DIN, (bf16*)(wb + WO_WBS), nb * 32, nb * 32, kb * 64, scr, lane, a.in[21] + (size_t)l * DIN); continue; }
        r -= IBS;
        { const int kb = r / 32, nb = r % 32;
            transpose_item(a.in[24] + (size_t)l * DM * DM, DM, DM, (bf16*)(wb + WO_WO), nb * 32, nb * 32, kb * 64, scr, lane); }
    }
}
__device__ __forceinline__ void adaln_phase(const Args& a, LAS unsigned char* lds, int tid) {
    unsigned char* wsb = a.ws; asm volatile("" : "+s"(wsb));
    { unsigned z_ = 0; asm volatile("" : "+s"(z_)); lds += z_; }
    LAS float* sc = (LAS float*)lds;
    LAS float* red = (LAS float*)(lds + 36864);
    float* MOD = (float*)(wsb + WS_MOD);
    if ((int)blockIdx.x >= 288) return;
    for (int i = tid; i < 9 * 1024; i += NTHR) { const int r = i >> 10, k = i & 1023; const float v = r == 0 ? a.in[5][k] : a.in[4][(r - 1) * 1024 + k]; sc[i] = silu_f(v); }
    __syncthreads();
    const int cgp = tid & 15, kc = tid >> 4;
    for (int item = blockIdx.x; item < 288; item += gridDim.x) {
        const int l = item / 144, cgi = item % 144, col0 = cgi * 64 + 4 * cgp;
        const float* w = a.in[6] + ((size_t)l * 1024 + kc * 32) * 9216 + col0;
        f32x4 acc[9];
#pragma unroll
        for (int r = 0; r < 9; ++r) acc[r] = (f32x4){0.f, 0.f, 0.f, 0.f};
#pragma unroll 16
        for (int i = 0; i < 32; ++i) { const f32x4 w4 = *(const f32x4*)(w + (size_t)i * 9216);
#pragma unroll
            for (int r = 0; r < 9; ++r) acc[r] += w4 * sc[r * 1024 + kc * 32 + i]; }
#pragma unroll
        for (int r = 0; r < 9; ++r) *(LAS f32x4*)(red + (kc * 9 + r) * 64 + 4 * cgp) = acc[r];
        __syncthreads();
        for (int o = tid; o < 576; o += NTHR) { const int r = o >> 6, c = o & 63; float s = 0.f;
#pragma unroll 8
            for (int k = 0; k < 32; ++k) s += red[(k * 9 + r) * 64 + c];
            MOD[((size_t)l * 9 + r) * 9216 + cgi * 64 + c] = s + a.in[7][(size_t)l * 9216 + cgi * 64 + c]; }
        __syncthreads();
    }
}
__device__ __forceinline__ void normmod_phase(const Args& a, int l, int idx, bool use_in, bool has_d2, int gw, int ngw, int lane) {
    unsigned char* wsb = a.ws; asm volatile("" : "+s"(wsb));
    const float* MOD = (const float*)(wsb + WS_MOD) + (size_t)l * 9 * 9216;
    bf16* XB = (bf16*)a.out; bf16* H = (bf16*)(wsb + WS_H); const bf16* D2 = (const bf16*)(wsb + WS_D2);
    const float* gp = a.in[8] + ((size_t)l * 3 + idx) * DM;
    f32x4 gv[2][2];
#pragma unroll
    for (int j = 0; j < 2; ++j) { gv[j][0] = *(const f32x4*)(gp + 8 * (lane + 64 * j)); gv[j][1] = *(const f32x4*)(gp + 8 * (lane + 64 * j) + 4); }
    constexpr int R = 3;
    const int rpw = (((T_ALL + ngw - 1) / ngw + R - 1) / R) * R;
    const int rbeg = gw * rpw, rend = min(rbeg + rpw, T_ALL);
    int cur_mrow = -1; f32x4 gsc[2][2], shv[2][2];
#pragma unroll
    for (int j = 0; j < 2; ++j) { gsc[j][0] = gv[j][0]; gsc[j][1] = gv[j][1]; shv[j][0] = gv[j][0]; shv[j][1] = gv[j][1]; }
    for (int r0 = rbeg; r0 < rend; r0 += R) {
        f32x4 v[R][2][2]; float s[R];
        if (use_in) {
#pragma unroll
            for (int r = 0; r < R; ++r) { const int row = r0 + r;
                const float* srcp = row < T_CTX ? a.in[0] + (size_t)row * DM : a.in[1] + (size_t)(row - T_CTX) * DM;
#pragma unroll
                for (int j = 0; j < 2; ++j) { v[r][j][0] = *(const f32x4*)(srcp + 8 * (lane + 64 * j)); v[r][j][1] = *(const f32x4*)(srcp + 8 * (lane + 64 * j) + 4); } }
        } else {
            u32x4 q[R][2];
#pragma unroll
            for (int r = 0; r < R; ++r)
#pragma unroll
                for (int j = 0; j < 2; ++j) q[r][j] = *(const u32x4*)(XB + (size_t)(r0 + r) * DM + 8 * (lane + 64 * j));
#pragma unroll
            for (int r = 0; r < R; ++r)
#pragma unroll
                for (int j = 0; j < 2; ++j) { v[r][j][0] = (f32x4){blo(q[r][j].x), bhi(q[r][j].x), blo(q[r][j].y), bhi(q[r][j].y)}; v[r][j][1] = (f32x4){blo(q[r][j].z), bhi(q[r][j].z), blo(q[r][j].w), bhi(q[r][j].w)}; }
            if (has_d2 && r0 + R - 1 >= 32768) {
#pragma unroll
                for (int r = 0; r < R; ++r) { const int row = r0 + r;
                    if (row >= 32768) {
#pragma unroll
                        for (int j = 0; j < 2; ++j) { const u32x4 d = *(const u32x4*)(D2 + (size_t)(row - 32768) * DM + 8 * (lane + 64 * j));
                            v[r][j][0] += (f32x4){blo(d.x), bhi(d.x), blo(d.y), bhi(d.y)}; v[r][j][1] += (f32x4){blo(d.z), bhi(d.z), blo(d.w), bhi(d.w)};
                            u32x4 w; w.x = pk2(v[r][j][0].x, v[r][j][0].y); w.y = pk2(v[r][j][0].z, v[r][j][0].w); w.z = pk2(v[r][j][1].x, v[r][j][1].y); w.w = pk2(v[r][j][1].z, v[r][j][1].w);
                            *(u32x4*)(XB + (size_t)row * DM + 8 * (lane + 64 * j)) = w;
                            v[r][j][0] = (f32x4){blo(w.x), bhi(w.x), blo(w.y), bhi(w.y)}; v[r][j][1] = (f32x4){blo(w.z), bhi(w.z), blo(w.w), bhi(w.w)}; } } }
            }
        }
#pragma unroll
        for (int r = 0; r < R; ++r) { s[r] = 0.f;
#pragma unroll
            for (int j = 0; j < 2; ++j)
#pragma unroll
                for (int h = 0; h < 2; ++h) s[r] += (v[r][j][h].x * v[r][j][h].x + v[r][j][h].y * v[r][j][h].y) + (v[r][j][h].z * v[r][j][h].z + v[r][j][h].w * v[r][j][h].w); }
#pragma unroll
        for (int o = 1; o < 64; o <<= 1) {
#pragma unroll
            for (int r = 0; r < R; ++r) s[r] += __shfl_xor(s[r], o); }
#pragma unroll
        for (int r = 0; r < R; ++r) { const int row = r0 + r;
            const int mrow = row < T_CTX ? 0 : 1 + ((row - T_CTX) >> 12);
            if (mrow != cur_mrow) {
                cur_mrow = mrow;
                const float* sh = MOD + (size_t)mrow * 9216 + (3 * idx) * DM;
                const float* scl = MOD + (size_t)mrow * 9216 + (3 * idx + 1) * DM;
#pragma unroll
                for (int j = 0; j < 2; ++j)
#pragma unroll
                    for (int h = 0; h < 2; ++h) { gsc[j][h] = gv[j][h] * (*(const f32x4*)(scl + 8 * (lane + 64 * j) + 4 * h) + 1.0f); shv[j][h] = *(const f32x4*)(sh + 8 * (lane + 64 * j) + 4 * h); }
            }
            const float rstd = __builtin_amdgcn_rsqf((s[r] + EPS * DM) * (1.f / DM));
#pragma unroll
            for (int j = 0; j < 2; ++j) { const f32x4 h0 = (v[r][j][0] * rstd) * gsc[j][0] + shv[j][0], h1 = (v[r][j][1] * rstd) * gsc[j][1] + shv[j][1];
                u32x4 w; w.x = pk2(h0.x, h0.y); w.y = pk2(h0.z, h0.w); w.z = pk2(h1.x, h1.y); w.w = pk2(h1.z, h1.w);
                *(u32x4*)(H + (size_t)row * DM + 8 * (lane + 64 * j)) = w; } }
    }
}
__device__ __forceinline__ void final_norm_phase(const Args& a, bool has_d2, int gw, int ngw, int lane) {
    unsigned char* wsb = a.ws; asm volatile("" : "+s"(wsb));
    float* OUT = a.out; const bf16* XW = (const bf16*)(wsb + WS_RB); const bf16* D2 = (const bf16*)(wsb + WS_D2);
    const float* gp = a.in[25];
    f32x4 gv[2][2];
#pragma unroll
    for (int j = 0; j < 2; ++j) { gv[j][0] = *(const f32x4*)(gp + 8 * (lane + 64 * j)); gv[j][1] = *(const f32x4*)(gp + 8 * (lane + 64 * j) + 4); }
    constexpr int R = 3;
    for (int r0 = gw * R; r0 < T_ALL; r0 += ngw * R) {
        u32x4 q[R][2]; f32x4 v[R][2][2]; float s[R];
#pragma unroll
        for (int r = 0; r < R; ++r)
#pragma unroll
            for (int j = 0; j < 2; ++j) q[r][j] = *(const u32x4*)(XW + (size_t)(r0 + r) * DM + 8 * (lane + 64 * j));
#pragma unroll
        for (int r = 0; r < R; ++r)
#pragma unroll
            for (int j = 0; j < 2; ++j) { v[r][j][0] = (f32x4){blo(q[r][j].x), bhi(q[r][j].x), blo(q[r][j].y), bhi(q[r][j].y)}; v[r][j][1] = (f32x4){blo(q[r][j].z), bhi(q[r][j].z), blo(q[r][j].w), bhi(q[r][j].w)}; }
        if (has_d2 && r0 + R - 1 >= 32768) {
#pragma unroll
            for (int r = 0; r < R; ++r) if (r0 + r >= 32768) {
#pragma unroll
                for (int j = 0; j < 2; ++j) { const u32x4 d = *(const u32x4*)(D2 + (size_t)(r0 + r - 32768) * DM + 8 * (lane + 64 * j));
                    v[r][j][0] += (f32x4){blo(d.x), bhi(d.x), blo(d.y), bhi(d.y)}; v[r][j][1] += (f32x4){blo(d.z), bhi(d.z), blo(d.w), bhi(d.w)}; } }
        }
#pragma unroll
        for (int r = 0; r < R; ++r) { s[r] = 0.f;
#pragma unroll
            for (int j = 0; j < 2; ++j)
#pragma unroll
                for (int h = 0; h < 2; ++h) s[r] += (v[r][j][h].x * v[r][j][h].x + v[r][j][h].y * v[r][j][h].y) + (v[r][j][h].z * v[r][j][h].z + v[r][j][h].w * v[r][j][h].w); }
#pragma unroll
        for (int o = 1; o < 64; o <<= 1) {
#pragma unroll
            for (int r = 0; r < R; ++r) s[r] += __shfl_xor(s[r], o); }
#pragma unroll
        for (int r = 0; r < R; ++r) { const float rstd = __builtin_amdgcn_rsqf((s[r] + EPS * DM) * (1.f / DM)); float* orow = OUT + (size_t)(r0 + r) * DM;
#pragma unroll
            for (int j = 0; j < 2; ++j) { *(f32x4*)(orow + 8 * (lane + 64 * j)) = v[r][j][0] * rstd * gv[j][0]; *(f32x4*)(orow + 8 * (lane + 64 * j) + 4) = v[r][j][1] * rstd * gv[j][1]; } }
    }
}
__device__ __forceinline__ void unpack8(const u32x4 q, float (&f)[8]) { f[0] = blo(q.x); f[1] = bhi(q.x); f[2] = blo(q.y); f[3] = bhi(q.y); f[4] = blo(q.z); f[5] = bhi(q.z); f[6] = blo(q.w); f[7] = bhi(q.w); }
__device__ __forceinline__ u32x4 pack8(const float (&f)[8]) { u32x4 w; w.x = pk2(f[0], f[1]); w.y = pk2(f[2], f[3]); w.z = pk2(f[4], f[5]); w.w = pk2(f[6], f[7]); return w; }
__device__ __forceinline__ void conv_phase(const Args& a, int l, int t_begin, int t_count, int raw_off, int gw, int ngw, int lane) {
    unsigned char* wsb = a.ws; asm volatile("" : "+s"(wsb));
    const bf16* RAW = (const bf16*)(wsb + WS_RB); bf16* XH = (bf16*)(wsb + WS_RA + RA_XH); bf16* BG = (bf16*)(wsb + WS_RA + RA_BG); bf16* CG = (bf16*)(wsb + WS_RA + RA_CG);
    const int nitems = (t_count / 16) * 6;
    int convd = CONVD; asm volatile("" : "+s"(convd));
    for (int it = gw; it < nitems; it += ngw) {
        const int cb = it % 6, run = it / 6, t0 = t_begin + run * 16, ch = cb * 512 + lane * 8;
        int s0, e0; if (t0 < T_CTX) { s0 = t0 & ~255; e0 = s0 + 256; } else { s0 = T_CTX + ((t0 - T_CTX) & ~4095); e0 = s0 + 4096; }
        float w[4][8], b[8];
#pragma unroll
        for (int k = 0; k < 4; ++k) { const f32x4 w0 = *(const f32x4*)(a.in[16] + ((size_t)l * 4 + k) * CONVD + ch), w1 = *(const f32x4*)(a.in[16] + ((size_t)l * 4 + k) * CONVD + ch + 4);
            w[k][0] = w0.x; w[k][1] = w0.y; w[k][2] = w0.z; w[k][3] = w0.w; w[k][4] = w1.x; w[k][5] = w1.y; w[k][6] = w1.z; w[k][7] = w1.w; }
        { const f32x4 b0 = *(const f32x4*)(a.in[17] + (size_t)l * CONVD + ch), b1 = *(const f32x4*)(a.in[17] + (size_t)l * CONVD + ch + 4);
            b[0] = b0.x; b[1] = b0.y; b[2] = b0.z; b[3] = b0.w; b[4] = b1.x; b[5] = b1.y; b[6] = b1.z; b[7] = b1.w; }
        bf16* dst; int dstride;
        if (ch < 2048) { dst = XH + (size_t)(ch >> 6) * T_ALL * 64 + (ch & 63); dstride = 64; }
        else if (ch < 2560) { dst = BG + (size_t)((ch - 2048) >> 7) * T_ALL * 128 + ((ch - 2048) & 127); dstride = 128; }
        else { dst = CG + (size_t)((ch - 2560) >> 7) * T_ALL * 128 + ((ch - 2560) & 127); dstride = 128; }
        u32x4 rw[19];
#pragma unroll
        for (int i = 0; i < 19; ++i) { const int t = t0 - 2 + i; rw[i] = (t >= s0 && t < e0) ? *(const u32x4*)(RAW + (size_t)(t - t_begin + raw_off) * convd + ch) : (u32x4){0u, 0u, 0u, 0u}; }
        float xm2[8], xm1[8], x0[8], xp1[8];
        unpack8(rw[0], xm2); unpack8(rw[1], xm1); unpack8(rw[2], x0);
#pragma unroll
        for (int i = 0; i < 16; ++i) {
            unpack8(rw[i + 3], xp1);
            float o[8];
#pragma unroll
            for (int c = 0; c < 8; ++c) { const float v = b[c] + w[0][c] * xm2[c] + w[1][c] * xm1[c] + w[2][c] * x0[c] + w[3][c] * xp1[c]; o[c] = silu_f(v); }
            *(u32x4*)(dst + (size_t)(t0 + i) * dstride) = pack8(o);
#pragma unroll
            for (int c = 0; c < 8; ++c) { xm2[c] = xm1[c]; xm1[c] = x0[c]; x0[c] = xp1[c]; }
        }
    }
}
template <int W>
__device__ __forceinline__ void hpool_g(const bf16* U, bf16* HS, int g, int gt, int ngt) {
    const int n = T_ALL * 32;
    for (int i = gt; i < n; i += ngt) {
        const int t = i >> 5, chunk = g * 32 + (i & 31);
        const bool ctx = t < T_CTX;
        const int c = ctx ? (t & 255) : ((t - T_CTX) & 63), lim = ctx ? 256 : 64;
        u32x4 q[W];
#pragma unroll
        for (int j = 0; j < W; ++j) { const int cc = c - W / 2 + j; const bool ok = (unsigned)cc < (unsigned)lim;
            q[j] = ok ? *(const u32x4*)(U + (size_t)(t - c + cc) * DM + chunk * 8) : (u32x4){0u, 0u, 0u, 0u}; }
        float s[8] = {0.f, 0.f, 0.f, 0.f, 0.f, 0.f, 0.f, 0.f};
#pragma unroll
        for (int j = 0; j < W; ++j) { float f[8]; unpack8(q[j], f);
#pragma unroll
            for (int k = 0; k < 8; ++k) s[k] += f[k]; }
        *(u32x4*)(HS + (size_t)t * DM + chunk * 8) = pack8(s);
    }
}
__device__ __forceinline__ void hpool_phase(const Args& a, int gt, int ngt) {
    unsigned char* wsb = a.ws; asm volatile("" : "+s"(wsb));
    const bf16* U = (const bf16*)(wsb + WS_RA + RA_U); bf16* HS = (bf16*)(wsb + WS_H);
    hpool_g<2>(U, HS, 0, gt, ngt); hpool_g<4>(U, HS, 1, gt, ngt); hpool_g<8>(U, HS, 2, gt, ngt); hpool_g<16>(U, HS, 3, gt, ngt);
}
template <int W>
__device__ __forceinline__ void vpool_g(bf16* U, const bf16* HS, int g, int gt, int ngt) {
    const int n = T_ALL * 32;
    for (int i = gt; i < n; i += ngt) {
        const int t = i >> 5, chunk = g * 32 + (i & 31);
        float s[8] = {0.f, 0.f, 0.f, 0.f, 0.f, 0.f, 0.f, 0.f}; float cnt;
        if (t < T_CTX) {
            const int p = t & 255;
            unpack8(*(const u32x4*)(HS + (size_t)t * DM + chunk * 8), s);
            cnt = (float)(min(p - W / 2 + W, 256) - max(p - W / 2, 0));
        } else {
            const int pos = (t - T_CTX) & 4095, c = pos & 63, r = pos >> 6;
            u32x4 q[W];
#pragma unroll
            for (int j = 0; j < W; ++j) { const int rr = r - W / 2 + j; const bool ok = (unsigned)rr < 64u;
                q[j] = ok ? *(const u32x4*)(HS + (size_t)(t + (rr - r) * 64) * DM + chunk * 8) : (u32x4){0u, 0u, 0u, 0u}; }
#pragma unroll
            for (int j = 0; j < W; ++j) { float f[8]; unpack8(q[j], f);
#pragma unroll
                for (int k = 0; k < 8; ++k) s[k] += f[k]; }
            cnt = (float)((min(r - W / 2 + W, 64) - max(r - W / 2, 0)) * (min(c - W / 2 + W, 64) - max(c - W / 2, 0)));
        }
        float u[8]; unpack8(*(const u32x4*)(U + (size_t)t * DM + chunk * 8), u);
        const float inv = 1.0f / cnt;
#pragma unroll
        for (int k = 0; k < 8; ++k) s[k] = s[k] * inv - u[k];
        *(u32x4*)(U + (size_t)t * DM + chunk * 8) = pack8(s);
    }
}
__device__ __forceinline__ void vpool_phase(const Args& a, int gt, int ngt) {
    unsigned char* wsb = a.ws; asm volatile("" : "+s"(wsb));
    bf16* U = (bf16*)(wsb + WS_RA + RA_U); const bf16* HS = (const bf16*)(wsb + WS_H);
    vpool_g<2>(U, HS, 0, gt, ngt); vpool_g<4>(U, HS, 1, gt, ngt); vpool_g<8>(U, HS, 2, gt, ngt); vpool_g<16>(U, HS, 3, gt, ngt);
}
__device__ __forceinline__ void gatednorm_phase(const Args& a, int l, int gw, int ngw, int lane) {
    const bf16* Z = (const bf16*)(a.ws + WS_RA + RA_Z); bf16* Y = (bf16*)(a.ws + WS_RB);
    const float* g = a.in[21] + (size_t)l * DIN;
    constexpr int R = 2;
    for (int t0 = gw * R; t0 < T_ALL; t0 += ngw * R) {
        u32x4 yq[R][4], zq[R][4];
#pragma unroll
        for (int r = 0; r < R; ++r) { const bf16* yr = Y + (size_t)(t0 + r) * DIN; const bf16* zr = Z + (size_t)(t0 + r) * DIN;
#pragma unroll
            for (int j = 0; j < 4; ++j) { yq[r][j] = *(const u32x4*)(yr + (j * 64 + lane) * 8); zq[r][j] = *(const u32x4*)(zr + (j * 64 + lane) * 8); } }
        float s[R];
#pragma unroll
        for (int r = 0; r < R; ++r) { s[r] = 0.f;
#pragma unroll
            for (int j = 0; j < 4; ++j) { float y[8], z[8]; unpack8(yq[r][j], y); unpack8(zq[r][j], z);
#pragma unroll
                for (int k = 0; k < 8; ++k) { y[k] = y[k] * silu_f(z[k]); s[r] += y[k] * y[k]; }
                yq[r][j] = (u32x4){__float_as_uint(y[0]), __float_as_uint(y[1]), __float_as_uint(y[2]), __float_as_uint(y[3])};
                zq[r][j] = (u32x4){__float_as_uint(y[4]), __float_as_uint(y[5]), __float_as_uint(y[6]), __float_as_uint(y[7])}; } }
#pragma unroll
        for (int o = 1; o < 64; o <<= 1) {
#pragma unroll
            for (int r = 0; r < R; ++r) s[r] += __shfl_xor(s[r], o); }
#pragma unroll
        for (int r = 0; r < R; ++r) { const float rstd = __builtin_amdgcn_rsqf(s[r] * (1.f / DIN) + EPS); bf16* yr = Y + (size_t)(t0 + r) * DIN;
#pragma unroll
            for (int j = 0; j < 4; ++j) { const f32x4 g0 = *(const f32x4*)(g + (j * 64 + lane) * 8), g1 = *(const f32x4*)(g + (j * 64 + lane) * 8 + 4);
                float o[8] = {__uint_as_float(yq[r][j].x) * rstd * g0.x, __uint_as_float(yq[r][j].y) * rstd * g0.y, __uint_as_float(yq[r][j].z) * rstd * g0.z, __uint_as_float(yq[r][j].w) * rstd * g0.w,
                              __uint_as_float(zq[r][j].x) * rstd * g1.x, __uint_as_float(zq[r][j].y) * rstd * g1.y, __uint_as_float(zq[r][j].z) * rstd * g1.z, __uint_as_float(zq[r][j].w) * rstd * g1.w};
                *(u32x4*)(yr + (j * 64 + lane) * 8) = pack8(o); } }
    }
}
constexpr int RS_BC = 272, RS_X = 160;
constexpr int L_BI = 0, L_CI = 34816, L_XI = 69632, L_HI = 90112, L_CS = 110592, L_DTV = L_CS + 512, L_WV = L_CS + 1024, L_TOT = L_CS + 1536;
__device__ __forceinline__ s16x4 trd(LAS unsigned char* p) { return __builtin_amdgcn_ds_read_tr16_b64_v4i16((LAS s16x4*)p); }
__device__ __forceinline__ bf16x8 cat4(s16x4 a, s16x4 b) { return (bf16x8){a[0], a[1], a[2], a[3], b[0], b[1], b[2], b[3]}; }
#define MFMA16(A, B, C) __builtin_amdgcn_mfma_f32_16x16x32_bf16((A), (B), (C), 0, 0, 0)

template <bool BWD>
__device__ __forceinline__ void ssd_sweep(LAS unsigned char* lds, const bf16* XH, const bf16* BG, const bf16* CG, const float* DT, bf16* YH, int tok0, int nc, int h, float aneg, float dskip,
                                          const float* h0, float* hout, int tid, int wave, int lane) {
    const int grp = h >> 3, dcol = (BWD ? 32 : 0) + h, scanw = BWD ? 7 : 0;
    const int cl = lane & 15, g = lane >> 4, q4 = (lane & 15) >> 2, pp = lane & 3;
    const int lcol = 16 * wave + cl;
    f32x4 hacc[4];
#pragma unroll
    for (int pt = 0; pt < 4; ++pt)
#pragma unroll
        for (int j = 0; j < 4; ++j) hacc[pt][j] = h0 ? h0[(size_t)(16 * pt + 4 * g + j) * 128 + lcol] : 0.f;
    u32x4 st[10]; float dts0 = 0.f, dts1 = 0.f; u32x2 yprev[4] = {(u32x2){0u, 0u}, (u32x2){0u, 0u}, (u32x2){0u, 0u}, (u32x2){0u, 0u}};
#define SSD_SB() __builtin_amdgcn_sched_barrier(0)
#define SSD_LOAD_CHUNK(c_) do { const int tokc_ = tok0 + (c_) * 128; \
        _Pragma("unroll") for (int r = 0; r < 2; ++r) { const int q = tid + 512 * r, row = q >> 3, c16 = q & 7; st[r] = *(const u32x4*)(XH + ((size_t)h * T_ALL + tokc_ + row) * 64 + c16 * 8); } \
        _Pragma("unroll") for (int r = 0; r < 4; ++r) { const int q = tid + 512 * r, row = q >> 4, c16 = q & 15; st[2 + r] = *(const u32x4*)(BG + ((size_t)grp * T_ALL + tokc_ + row) * 128 + c16 * 8); } \
        _Pragma("unroll") for (int r = 0; r < 4; ++r) { const int q = tid + 512 * r, row = q >> 4, c16 = q & 15; st[6 + r] = *(const u32x4*)(CG + ((size_t)grp * T_ALL + tokc_ + row) * 128 + c16 * 8); } \
        if (wave == scanw) { dts0 = DT[(size_t)(tokc_ + lane) * 64 + dcol]; dts1 = DT[(size_t)(tokc_ + 64 + lane) * 64 + dcol]; } \
        if (!BWD) { const bf16* yq = YH + (size_t)(tokc_ + lcol) * DIN + h * 64 + 4 * g; _Pragma("unroll") for (int pt = 0; pt < 4; ++pt) yprev[pt] = *(const u32x2*)(yq + 16 * pt); } \
    } while (0)
#define SSD_SCAN(cb_) do { if (wave == scanw) { \
        const float da0 = dts0 * aneg, da1 = dts1 * aneg; float p0 = da0, p1 = da1; \
        _Pragma("unroll") for (int o = 1; o < 64; o <<= 1) { const float t0 = __shfl_up(p0, o), t1 = __shfl_up(p1, o); if (lane >= o) { p0 += t0; p1 += t1; } } \
        const float tot0 = __shfl(p0, 63), tot1 = __shfl(p1, 63), total = tot0 + tot1; p1 += tot0; \
        const float c0 = BWD ? total - p0 + da0 : p0, c1 = BWD ? total - p1 + da1 : p1; \
        LAS float* CS = (LAS float*)(lds + (cb_)); \
        CS[lane] = c0; CS[64 + lane] = c1; CS[128 + lane] = dts0; CS[192 + lane] = dts1; \
        CS[256 + lane] = dts0 * fexp(total - c0); CS[320 + lane] = dts1 * fexp(total - c1); \
        if (lane == 0) CS[384] = total; } } while (0)
    if (BWD ? (wave < 4) : (wave >= 4)) __builtin_amdgcn_s_setprio(2);
    SSD_LOAD_CHUNK(BWD ? nc - 1 : 0);
    SSD_SCAN(L_CS);
    for (int step = 0; step < nc; ++step) {
        const int c = BWD ? nc - 1 - step : step;
        const int tokc = tok0 + c * 128;
        const int csb = L_CS + (step & 1) * 2048;
#pragma unroll
        for (int r = 0; r < 2; ++r) { const int q = tid + 512 * r, row = q >> 3, c16 = q & 7; *(LAS u32x4*)(lds + L_XI + row * RS_X + c16 * 16) = st[r]; }
#pragma unroll
        for (int r = 0; r < 4; ++r) { const int q = tid + 512 * r, row = q >> 4, c16 = q & 15; *(LAS u32x4*)(lds + L_BI + row * RS_BC + c16 * 16) = st[2 + r]; }
#pragma unroll
        for (int r = 0; r < 4; ++r) { const int q = tid + 512 * r, row = q >> 4, c16 = q & 15; *(LAS u32x4*)(lds + L_CI + row * RS_BC + c16 * 16) = st[6 + r]; }
#pragma unroll
        for (int pt = 0; pt < 4; ++pt) { u32x2 w; w.x = pk2(hacc[pt][0], hacc[pt][1]); w.y = pk2(hacc[pt][2], hacc[pt][3]);
            *(LAS u32x2*)(lds + L_HI + lcol * RS_X + (16 * pt + 4 * g) * 2) = w; }
        u32x2 ycur[4];
#pragma unroll
        for (int pt = 0; pt < 4; ++pt) ycur[pt] = yprev[pt];
        if (step + 1 < nc) SSD_LOAD_CHUNK(BWD ? c - 1 : c + 1);
        __syncthreads();
        {
            const float csl = *(LAS float*)(lds + csb + lcol * 4);
            bf16x8 cf[4];
#pragma unroll
            for (int k = 0; k < 4; ++k) cf[k] = *(LAS bf16x8*)(lds + L_CI + lcol * RS_BC + (32 * k + 8 * g) * 2);
            f32x4 yacc[4];
#pragma unroll
            for (int pt = 0; pt < 4; ++pt) yacc[pt] = (f32x4){0.f, 0.f, 0.f, 0.f};
            bf16x8 hf[2][4];
#define SSD_LD_H(buf_, k_) do { _Pragma("unroll") for (int pt = 0; pt < 4; ++pt) { LAS unsigned char* p0 = lds + L_HI + (32 * (k_) + 8 * g + q4) * RS_X + (16 * pt) * 2 + 8 * pp; \
                hf[buf_][pt] = cat4(trd(p0), trd(p0 + 4 * RS_X)); } } while (0)
            SSD_LD_H(0, 0);
            SSD_SB();
#pragma unroll
            for (int k = 0; k < 4; ++k) {
                if (k < 3) SSD_LD_H((k + 1) & 1, k + 1);
#pragma unroll
                for (int pt = 0; pt < 4; ++pt) yacc[pt] = MFMA16(hf[k & 1][pt], cf[k], yacc[pt]);
                SSD_SB();
            }
            const float el = fexp(csl);
#pragma unroll
            for (int pt = 0; pt < 4; ++pt) yacc[pt] *= el;
#pragma unroll 1
            for (int sb = 0; sb < 4; ++sb) {
                const bool need = BWD ? (2 * sb + 1 >= wave) : (2 * sb <= wave);
                if (!need) continue;
                bf16x8 ba[2][4]; f32x4 css[2], dtv[2]; bf16x8 xa[4];
#pragma unroll
                for (int u = 0; u < 2; ++u) {
#pragma unroll
                    for (int k = 0; k < 4; ++k) ba[u][k] = *(LAS bf16x8*)(lds + L_BI + (32 * sb + 16 * u + cl) * RS_BC + (32 * k + 8 * g) * 2);
                    css[u] = *(LAS f32x4*)(lds + csb + (32 * sb + 16 * u + 4 * g) * 4); dtv[u] = *(LAS f32x4*)(lds + csb + 512 + (32 * sb + 16 * u + 4 * g) * 4); }
#pragma unroll
                for (int pt = 0; pt < 4; ++pt) { LAS unsigned char* p0 = lds + L_XI + (32 * sb + 4 * g + q4) * RS_X + (16 * pt) * 2 + 8 * pp; xa[pt] = cat4(trd(p0), trd(p0 + 16 * RS_X)); }
                SSD_SB();
                f32x4 sacc[2] = {(f32x4){0.f, 0.f, 0.f, 0.f}, (f32x4){0.f, 0.f, 0.f, 0.f}};
#pragma unroll
                for (int k = 0; k < 4; ++k) { sacc[0] = MFMA16(ba[0][k], cf[k], sacc[0]); sacc[1] = MFMA16(ba[1][k], cf[k], sacc[1]); }
                f32x4 m[2];
#pragma unroll
                for (int u = 0; u < 2; ++u)
#pragma unroll
                    for (int j = 0; j < 4; ++j) { const int s = 32 * sb + 16 * u + 4 * g + j; const bool valid = BWD ? (s >= lcol) : (s <= lcol);
                        float v = valid ? sacc[u][j] * fexp(fminf(csl - css[u][j], 0.f)) * dtv[u][j] : 0.f;
                        if (!BWD && s == lcol) v += dskip;
                        m[u][j] = v; }
                u32x4 mw; mw.x = pk2(m[0][0], m[0][1]); mw.y = pk2(m[0][2], m[0][3]); mw.z = pk2(m[1][0], m[1][1]); mw.w = pk2(m[1][2], m[1][3]);
                const bf16x8 mf = __builtin_bit_cast(bf16x8, mw);
#pragma unroll
                for (int pt = 0; pt < 4; ++pt) yacc[pt] = MFMA16(xa[pt], mf, yacc[pt]);
                SSD_SB();
            }
            bf16* yp = YH + (size_t)(tokc + lcol) * DIN + h * 64 + 4 * g;
#pragma unroll
            for (int pt = 0; pt < 4; ++pt) { f32x4 v = yacc[pt];
                if (!BWD) { v[0] += blo(ycur[pt].x); v[1] += bhi(ycur[pt].x); v[2] += blo(ycur[pt].y); v[3] += bhi(ycur[pt].y); }
                u32x2 w; w.x = pk2(v[0], v[1]); w.y = pk2(v[2], v[3]); *(u32x2*)(yp + 16 * pt) = w; }
            const float dec = fexp(*(LAS float*)(lds + csb + 1536));
#pragma unroll
            for (int pt = 0; pt < 4; ++pt) hacc[pt] *= dec;
            s16x4 sb0[2], sb1[2]; f32x4 sw0[2], sw1[2]; bf16x8 sx[2][4];
#define SSD_LD_S(buf_, k_) do { LAS unsigned char* pb = lds + L_BI + (32 * (k_) + 8 * g + q4) * RS_BC + (16 * wave) * 2 + 8 * pp; \
                sb0[buf_] = trd(pb); sb1[buf_] = trd(pb + 4 * RS_BC); \
                sw0[buf_] = *(LAS f32x4*)(lds + csb + 1024 + (32 * (k_) + 8 * g) * 4); sw1[buf_] = *(LAS f32x4*)(lds + csb + 1024 + (32 * (k_) + 8 * g + 4) * 4); \
                _Pragma("unroll") for (int pt = 0; pt < 4; ++pt) { LAS unsigned char* p0 = lds + L_XI + (32 * (k_) + 8 * g + q4) * RS_X + (16 * pt) * 2 + 8 * pp; sx[buf_][pt] = cat4(trd(p0), trd(p0 + 4 * RS_X)); } } while (0)
            SSD_LD_S(0, 0);
            SSD_SB();
#pragma unroll
            for (int k = 0; k < 4; ++k) {
                if (k < 3) SSD_LD_S((k + 1) & 1, k + 1);
                const s16x4 b0 = sb0[k & 1], b1 = sb1[k & 1]; const f32x4 w0 = sw0[k & 1], w1 = sw1[k & 1];
                u32x4 bw;
                bw.x = pk2(__uint_as_float((unsigned)(unsigned short)b0[0] << 16) * w0[0], __uint_as_float((unsigned)(unsigned short)b0[1] << 16) * w0[1]);
                bw.y = pk2(__uint_as_float((unsigned)(unsigned short)b0[2] << 16) * w0[2], __uint_as_float((unsigned)(unsigned short)b0[3] << 16) * w0[3]);
                bw.z = pk2(__uint_as_float((unsigned)(unsigned short)b1[0] << 16) * w1[0], __uint_as_float((unsigned)(unsigned short)b1[1] << 16) * w1[1]);
                bw.w = pk2(__uint_as_float((unsigned)(unsigned short)b1[2] << 16) * w1[2], __uint_as_float((unsigned)(unsigned short)b1[3] << 16) * w1[3]);
                const bf16x8 bfr = __builtin_bit_cast(bf16x8, bw);
#pragma unroll
                for (int pt = 0; pt < 4; ++pt) hacc[pt] = MFMA16(sx[k & 1][pt], bfr, hacc[pt]);
                SSD_SB();
            }
            if (step + 1 < nc) SSD_SCAN(L_CS + ((step + 1) & 1) * 2048);
        }
        __syncthreads();
    }
    __builtin_amdgcn_s_setprio(0);
#undef SSD_LD_H
#undef SSD_LD_S
#undef SSD_SCAN
#undef SSD_LOAD_CHUNK
#undef SSD_SB
    if (hout) {
#pragma unroll
        for (int pt = 0; pt < 4; ++pt)
#pragma unroll
            for (int j = 0; j < 4; ++j) hout[(size_t)(16 * pt + 4 * g + j) * 128 + lcol] = hacc[pt][j];
    }
}
__device__ __forceinline__ void ssd_phase(const Args& a, int l, LAS unsigned char* lds, int vcu, int G, int tid, int wave, int lane) {
    unsigned char* wsb = a.ws; asm volatile("" : "+s"(wsb));
    { unsigned z_ = 0; asm volatile("" : "+s"(z_)); lds += z_; }
    const bf16* XH = (const bf16*)(wsb + WS_RA + RA_XH); const bf16* BG = (const bf16*)(wsb + WS_RA + RA_BG); const bf16* CG = (const bf16*)(wsb + WS_RA + RA_CG);
    const float* DT = (const float*)(wsb + WS_DT); bf16* YH = (bf16*)(wsb + WS_RB);
    for (int item = vcu; item < 256 + 512; item += G) {
        int tok0, nc, h; const float *h0f = nullptr, *h0b = nullptr; float *hof = nullptr, *hob = nullptr;
        if (item < 256) { const int b = item >> 5; h = item & 31; tok0 = T_CTX + b * 4096; nc = 32;
            h0f = a.in[2] + ((size_t)(b * 2 + l) * 32 + h) * 8192; h0b = a.in[3] + ((size_t)(b * 2 + l) * 32 + h) * 8192; }
        else { const int i2 = item - 256, b = i2 >> 5; h = i2 & 31; tok0 = b * 256; nc = 2;
            hof = a.out + OUT_SF + ((size_t)(b * 2 + l) * 32 + h) * 8192; hob = a.out + OUT_SB + ((size_t)(b * 2 + l) * 32 + h) * 8192; }
        const float af = -fexp(a.in[18][(size_t)l * 64 + h]), ab = -fexp(a.in[18][(size_t)l * 64 + 32 + h]);
        const float dsk = a.in[20][(size_t)l * 32 + h];
        ssd_sweep<true>(lds, XH, BG, CG, DT, YH, tok0, nc, h, ab, dsk, h0b, hob, tid, wave, lane);
        ssd_sweep<false>(lds, XH, BG, CG, DT, YH, tok0, nc, h, af, dsk, h0f, hof, tid, wave, lane);
    }
}

#define XB_TMO      128
#define XB_XCNT(j)  (256  + 64 * (j))
#define XB_XSUB(j)  (1280 + 64 * (j))
#define XB_XGEN(j)  (2304 + 64 * (j))
#define XB_TOP      3328
#define XB_TOPGEN   3392
#define XCD_BAR_WORDS 3456
#define XB_SPIN_CAP (1u << 18)

__device__ __forceinline__ unsigned xb_ld(unsigned* p)              { return __hip_atomic_load(p, __ATOMIC_RELAXED, __HIP_MEMORY_SCOPE_AGENT); }
__device__ __forceinline__ unsigned xb_add(unsigned* p, unsigned v) { return __hip_atomic_fetch_add(p, v, __ATOMIC_RELAXED, __HIP_MEMORY_SCOPE_AGENT); }
__device__ __forceinline__ unsigned xb_xcc_id() { return (unsigned)__builtin_amdgcn_s_getreg((3 << 11) | 20) & 0xFu; }
#define XB_SPIN(cond, bar) do { unsigned _sp = 0; while (cond) { __builtin_amdgcn_s_sleep(1); \
    if ((++_sp & 255u) == 0u) { if (xb_ld(&(bar)[XB_TMO])) break; if (_sp > XB_SPIN_CAP) { atomicAdd(&(bar)[XB_TMO], 1u); break; } } } } while (0)

struct XcdBarrier {
    unsigned* bar; unsigned x;
    volatile LAS unsigned* st;
};

__device__ __forceinline__ XcdBarrier xcd_barrier_post(unsigned* bar, volatile LAS unsigned* st) {
    XcdBarrier b; b.bar = bar; b.x = xb_xcc_id(); b.st = st;
    if (threadIdx.x == 0) (void)xb_add(&bar[XB_XCNT(b.x)], 1u);
    return b;
}
__device__ __forceinline__ void xcd_barrier_complete(unsigned* bar, unsigned x, unsigned& nloc, unsigned& nx) {
    const unsigned G = gridDim.x * gridDim.y * gridDim.z;
    unsigned sum, cnt, mine, sp = 0u;
    for (;;) {
        sum = 0u; cnt = 0u; mine = 0u;
#pragma unroll 1
        for (unsigned j = 0; j < 16; ++j) { const unsigned c = xb_ld(&bar[XB_XCNT(j)]); sum += c; cnt += (c > 0u) ? 1u : 0u; }
        mine = xb_ld(&bar[XB_XCNT(x)]);
        if (sum == G) break;
        __builtin_amdgcn_s_sleep(1);
        if ((++sp & 255u) == 0u) { if (xb_ld(&bar[XB_TMO])) break; if (sp > XB_SPIN_CAP) { atomicAdd(&bar[XB_TMO], 1u); break; } }
    }
    nloc = mine > 0u ? mine : 1u; nx = cnt > 0u ? cnt : 1u;
}

__device__ __forceinline__ void xcd_barrier(const XcdBarrier& b) {
    asm volatile("s_waitcnt vmcnt(0)" ::: "memory");
    __syncthreads();
    if (threadIdx.x == 0) {
        unsigned* bar = b.bar;
        __builtin_amdgcn_s_waitcnt(0);
        unsigned nloc = b.st[0], nx = b.st[1];
        if (nloc == 0u) { xcd_barrier_complete(bar, b.x, nloc, nx); b.st[0] = nloc; b.st[1] = nx; }
        const unsigned old = xb_add(&bar[XB_XSUB(b.x)], 1u);
        const unsigned gen = old / nloc;
        if (old + 1u == (gen + 1u) * nloc) {
            __builtin_amdgcn_fence(__ATOMIC_RELEASE, "agent");
            asm volatile("s_waitcnt vmcnt(0)" ::: "memory");
            const unsigned og = xb_add(&bar[XB_TOP], 1u);
            const unsigned tg = og / nx;
            if (og + 1u == (tg + 1u) * nx) xb_add(&bar[XB_TOPGEN], 1u);
            else XB_SPIN(xb_ld(&bar[XB_TOPGEN]) == tg, bar);
            __builtin_amdgcn_fence(__ATOMIC_ACQUIRE, "agent");
            xb_add(&bar[XB_XGEN(b.x)], 1u);
            asm volatile("s_waitcnt vmcnt(0)" ::: "memory");
        } else {
            XB_SPIN(xb_ld(&bar[XB_XGEN(b.x)]) == gen, bar);
            __builtin_amdgcn_fence(__ATOMIC_ACQUIRE, "agent");
            asm volatile("s_waitcnt vmcnt(0)" ::: "memory");
        }
    }
    __syncthreads();
}

__global__ void __launch_bounds__(NTHR, 2) hybrid_fwd(Args a) {
    extern __shared__ __attribute__((aligned(16))) unsigned char lds_raw[];
    LAS unsigned char* lds = (LAS unsigned char*)lds_raw;
    cg::grid_group grid = cg::this_grid();
    constexpr int G = 256; const int bid = blockIdx.x;
    const int vcu = (G % 8 == 0) ? (bid % 8) * (G / 8) + bid / 8 : bid;
    const int ngw = G * NWAVES, ngt = G * NTHR;
#define TIDS() int tid = threadIdx.x; asm volatile("" : "+v"(tid)); const int lane = tid & 63, wave = __builtin_amdgcn_readfirstlane(tid >> 6); const int gw = vcu * NWAVES + wave, gt = bid * NTHR + tid; (void)lane; (void)gw; (void)gt;
    unsigned char* ws = a.ws; unsigned char* wb = ws + WS_W;
    float* X = a.out; const float* MODB = (const float*)(ws + WS_MOD);
    const bf16* H = (const bf16*)(ws + WS_H);

    if (threadIdx.x < 64) ((LAS unsigned*)(lds + 131072))[threadIdx.x] = 0u;
    __syncthreads();
    XcdBarrier xbar = xcd_barrier_post((unsigned*)(ws + WS_BAR), (volatile LAS unsigned*)(lds + 131072));
#define GSYNC() xcd_barrier(xbar)
    constexpr bool split2 = true;
#define OPQ_S(v) asm volatile("" : "+s"(v))
#define PHV() int bid = blockIdx.x; OPQ_S(bid); unsigned char* ws = a.ws; OPQ_S(ws); unsigned char* wb = ws + WS_W; const bf16* H = (const bf16*)(ws + WS_H); float* X = a.out; (void)bid; (void)wb; (void)H; (void)X;
    { TIDS(); adaln_phase(a, lds, tid);
    __syncthreads();
    convert_phase(a, 0, lds, gw, ngw, wave, lane); }
    grid.sync();
#pragma unroll 1
    for (int l = 0; l < 2; ++l) {
        const float* mod = MODB + (size_t)l * 9 * 9216;
        if (l == 1) { TIDS(); convert_phase(a, 1, lds, gw, ngw, wave, lane); }
#pragma unroll 1
        for (int f = 0; f < 2; ++f) {
            if (f == 1) {
                { TIDS(); normmod_phase(a, l, 1, false, split2, gw, ngw, lane);
                  float* rss = (float*)(a.ws + WS_ROWSS); for (int i = gt; i < T_ALL; i += ngt) rss[i] = 0.f; }
                GSYNC();
#pragma unroll 1
                for (int hs = 0; hs < 2; ++hs) {
                    const int npc = hs ? 2 : 1;
#pragma unroll 1
                    for (int pc = 0; pc < npc; ++pc) {
                        const int tb = hs ? (pc ? 0 : 16384) : 1280, tcnt = hs ? (pc ? 1280 : 20480) : 15104, ro = (hs && !pc) ? 1280 : 0;
                        PHV(); const int cc = (hs && pc) ? ((bid >= 128 && bid < 193) ? bid - 128 : (1 << 20)) : bid;
                        pg8::Gemm g{H + (size_t)tb * DM, (const bf16*)(wb + WO_WINA), tcnt, NA_ROWS, DM, DM, DM, 0}; pg8::StaticOrder S; S.init(tcnt, NA_ROWS, G, cc);
                        pg8::EpiStore E{(bf16*)(ws + WS_RB) + (size_t)ro * CONVD, CONVD, 12, (float*)(ws + WS_DT) + (size_t)tb * 64, a.in[19] + (size_t)l * 64, 0, 0};
                        pg8::gemm_phase<pg8::EpiStore, pg8::StaticOrder>(lds, g, S, E);
                    }
                    GSYNC();
#pragma unroll 1
                    for (int pc = 0; pc < npc; ++pc) {
                        const int tb = hs ? (pc ? 0 : 16384) : 1280, tcnt = hs ? (pc ? 1280 : 20480) : 15104, ro = (hs && !pc) ? 1280 : 0;
                        TIDS(); conv_phase(a, l, tb, tcnt, ro, gw, ngw, lane);
                    }
                    GSYNC();
                }
                { TIDS(); ssd_phase(a, l, lds, vcu, G, tid, wave, lane); }
                GSYNC();
                { PHV(); pg8::Gemm g{H, (const bf16*)(wb + WO_WINB), T_ALL, DIN, DM, DM, DM, 0}; pg8::StaticOrder S; S.init(T_ALL, DIN, G, bid);
                  pg8::EpiYZ E{(bf16*)(ws + WS_RB), DIN, (float*)(ws + WS_ROWSS)};
                  pg8::gemm_phase<pg8::EpiYZ, pg8::StaticOrder>(lds, g, S, E); }
                GSYNC();
                { PHV(); pg8::Gemm g{H, (const bf16*)(wb + WO_WINB) + (size_t)DIN * DM, T_ALL, 3 * DM, DM, DM, DM, 0}; pg8::StaticOrder S; S.init(T_ALL, 3 * DM, G, bid);
                  pg8::EpiStore E{(bf16*)(ws + WS_RA + RA_U), DM, -1, nullptr, nullptr, 4, (size_t)T_ALL * DM};
                  pg8::gemm_phase<pg8::EpiStore, pg8::StaticOrder>(lds, g, S, E); }
                GSYNC();
                { TIDS(); hpool_phase(a, gt, ngt); }
                GSYNC();
                { TIDS(); vpool_phase(a, gt, ngt); }
                GSYNC();
                { PHV(); pg8::Gemm g{(const bf16*)(ws + WS_RB), (const bf16*)(wb + WO_WBS), T_ALL, DM, DIN, DIN, DIN, 0}; pg8::StaticOrder S; S.init(T_ALL, DM, G, bid);
                  pg8::EpiGate<3> E{(bf16*)(ws + WS_RA + RA_GB), DM, nullptr, (const bf16*)(ws + WS_RA + RA_GB), DM, (const float*)(ws + WS_ROWSS)};
                  pg8::gemm_phase<pg8::EpiGate<3>, pg8::StaticOrder>(lds, g, S, E); }
                { PHV(); const int nl = G / 4; pg8::Gemm g{(const bf16*)(ws + WS_RA + RA_U), (const bf16*)(wb + WO_PW), T_ALL, DM, 256, DM, 256, 512}; pg8::StaticOrder S; S.init(T_ALL, DM, G - nl, bid >= nl ? bid - nl : (1 << 20));
                  pg8::EpiGate<0> E{(bf16*)(ws + WS_H), DM, a.in[15] + (size_t)l * DM, nullptr, 0, nullptr};
                  pg8::gemm_phase<pg8::EpiGate<0>, pg8::StaticOrder>(lds, g, S, E); }
                GSYNC();
                { PHV(); pg8::Gemm g{H, (const bf16*)(wb + WO_WBP), T_ALL, DM, DM, DM, DM, 0}; pg8::StaticOrder S; S.init(T_ALL, DM, G, bid);
                  pg8::EpiGate<2> E{(bf16*)(ws + WS_RA + RA_GB), DM, nullptr, (const bf16*)(ws + WS_RA + RA_GA), DM, nullptr};
                  pg8::gemm_phase<pg8::EpiGate<2>, pg8::StaticOrder>(lds, g, S, E); }
                GSYNC();
                { PHV(); pg8::Gemm g{(const bf16*)(ws + WS_RA + RA_GB), (const bf16*)(wb + WO_WO), T_ALL, DM, DM, DM, DM, 0}; pg8::StaticOrder S; S.init(T_ALL, DM, G, bid);
                  pg8::EpiResid E{(const bf16*)X, (bf16*)X, a.in[0], a.in[1], mod, 5 * DM, 1.0f, 0, 0};
                  pg8::gemm_phase<pg8::EpiResid, pg8::StaticOrder>(lds, g, S, E); }
                GSYNC();
            }
            const bool use_in = (l == 0 && f == 0);
            { TIDS(); normmod_phase(a, l, f ? 2 : 0, use_in, split2 && f == 0 && l == 1, gw, ngw, lane); }
            GSYNC();
            { PHV(); pg8::Gemm g{H, (const bf16*)(wb + (f ? WO_W13B : WO_W13A)), T_ALL, 2 * DFF, DM, DM, DM, 0}; pg8::StaticOrder S; S.init(T_ALL, 2 * DFF, G, bid);
              pg8::EpiSwiGLU E{(bf16*)(ws + WS_RA), DFF};
              pg8::gemm_phase<pg8::EpiSwiGLU, pg8::StaticOrder>(lds, g, S, E); }
            GSYNC();
            {
              { PHV(); pg8::Gemm g{(const bf16*)(ws + WS_RA), (const bf16*)(wb + (f ? WO_W2B : WO_W2A)), T_ALL, DM, DFF, DFF, DFF, 0}; pg8::PanelOrder S{0, bid};
                pg8::EpiResid E{(const bf16*)X, (l == 1 && f == 1) ? (bf16*)(ws + WS_RB) : (bf16*)X, a.in[0], a.in[1], mod, (f ? 8 : 2) * DM, 0.5f, 0, use_in ? 1 : 0};
                pg8::gemm_phase<pg8::EpiResid, pg8::PanelOrder>(lds, g, S, E); }
              { PHV(); pg8::Gemm g{(const bf16*)(ws + WS_RA), (const bf16*)(wb + (f ? WO_W2B : WO_W2A)), T_ALL, DM, DFF / 2, DFF, DFF, 0}; pg8::PanelOrder S{1, bid};
                pg8::EpiResid E{(const bf16*)X, (l == 1 && f == 1) ? (bf16*)(ws + WS_RB) : (bf16*)X, a.in[0], a.in[1], mod, (f ? 8 : 2) * DM, 0.5f, 0, use_in ? 1 : 0};
                pg8::gemm_phase<pg8::EpiResid, pg8::PanelOrder>(lds, g, S, E); }
              { PHV(); pg8::Gemm g{(const bf16*)(ws + WS_RA) + DFF / 2, (const bf16*)(wb + (f ? WO_W2B : WO_W2A)) + DFF / 2, T_ALL, DM, DFF / 2, DFF, DFF, 0}; pg8::PanelOrder S{1, bid - 64};
                pg8::EpiDelta E{(bf16*)(ws + WS_D2), mod, (f ? 8 : 2) * DM, 0.5f};
                pg8::gemm_phase<pg8::EpiDelta, pg8::PanelOrder>(lds, g, S, E); }
            }
            GSYNC();
        }
    }
    { TIDS(); final_norm_phase(a, split2, gw, ngw, lane); }
}

extern "C" void kernel_launch(void* const* d_in, const int* in_sizes, int n_in, void* d_out, int out_size, void* d_ws, size_t ws_size, hipStream_t stream) {
    static int grid = 0;
    if (grid == 0) {
        if (n_in != 26 || ws_size < WS_END) { fprintf(stderr, "kernel_launch: unexpected n_in %d / ws_size %zu\n", n_in, ws_size); grid = -1; return; }
        int dev = 0, cus = 0, per_cu = 0;
        hipGetDevice(&dev);
        hipDeviceGetAttribute(&cus, hipDeviceAttributeMultiprocessorCount, dev);
        if (hipFuncSetAttribute((const void*)hybrid_fwd, hipFuncAttributeMaxDynamicSharedMemorySize, LDS_BYTES) != hipSuccess) { fprintf(stderr, "kernel_launch: hipFuncSetAttribute failed\n"); }
        if (hipOccupancyMaxActiveBlocksPerMultiprocessor(&per_cu, (const void*)hybrid_fwd, NTHR, LDS_BYTES) != hipSuccess || per_cu < 1) { fprintf(stderr, "kernel_launch: occupancy query gave %d\n", per_cu); per_cu = 1; }
        (void)hipGetLastError();
        grid = cus;
        if (grid != 256) { fprintf(stderr, "kernel_launch: built for a 256-CU device (got %d); nothing launched\n", grid); grid = -1; return; }
    }
    if (grid < 0) return;
    Args a{};
    for (int i = 0; i < 26; ++i) a.in[i] = (const float*)d_in[i];
    a.out = (float*)d_out; a.ws = (unsigned char*)d_ws;
    if (hipMemsetAsync((char*)d_ws + WS_BAR, 0, BAR_ZERO_BYTES, stream) != hipSuccess) { fprintf(stderr, "kernel_launch: memset failed\n"); return; }
    void* args[] = {&a};
    hipError_t e = hipLaunchCooperativeKernel((const void*)hybrid_fwd, dim3(grid), dim3(NTHR), args, LDS_BYTES, stream);
    if (e != hipSuccess) fprintf(stderr, "cooperative launch failed: %s (grid %d)\n", hipGetErrorString(e), grid);
}
```

```cpp
#include <hip/hip_runtime.h>
#include <hip/hip_cooperative_groups.h>
#include <cstdio>
#include <cstdint>
namespace pg8 {
#define PG8_LAS __attribute__((address_space(3)))
typedef unsigned short bf16_t;
typedef short bf16x8 __attribute__((ext_vector_type(8)));
typedef float f32x4 __attribute__((ext_vector_type(4)));
typedef unsigned u32x4 __attribute__((ext_vector_type(4)));
constexpr int BM = 256, BK = 64, HALF = 128, HTB = HALF * BK * 2  , STAGE_BYTES = 8 * HTB, NXCD = 8, WGM = 8;

__host__ __device__ __forceinline__ int lds_byte(int r, int c) { const int st = (r >> 4) * 2 + (c >> 5), rr = r & 15, cc = c & 31, ob = rr * 64 + cc * 2; return st * 1024 + (ob ^ (((ob >> 9) & 1) << 5)); }
__host__ __device__ __forceinline__ void stage_rc(int b, int& R, int& C) { const int st = b / 1024, sb = b % 1024, swz = sb ^ (((sb >> 9) & 1) << 5); R = (st >> 1) * 16 + swz / 64; C = (st & 1) * 32 + (swz % 64) / 2; }
__host__ __device__ __forceinline__ int perm32(int rho) { const int n = rho >> 4, i = rho & 15; return 8 * (i >> 2) + 4 * n + (i & 3); }

__device__ __forceinline__ float fexp(float x) { return __builtin_amdgcn_exp2f(x * 1.4426950408889634f); }
struct Unit { int pm, pn; };
struct Gemm { const bf16_t* A; const bf16_t* Bt; int M, N, K, lda, ldb, a_pn_bytes; };

struct StaticOrder {
    int nM, nN, nwg, G, c;
    __host__ __device__ void init(int M, int N, int G_, int c_) { nM = M / BM; nN = N / BM; nwg = nM * nN; G = G_; c = c_; }
    __host__ __device__ bool next(int i, Unit& u) const {
        const int L = i * G + c; if (L >= nwg) return false;
        int wgid = L; { const int q = nwg / NXCD, r = nwg % NXCD, xcd = wgid % NXCD, off = wgid / NXCD; wgid = (xcd < r ? xcd * (q + 1) : r * (q + 1) + (xcd - r) * q) + off; }
        const int nig = WGM * nN, gid = wgid / nig, fm = gid * WGM, gsz = (nM - fm) < WGM ? (nM - fm) : WGM;
        u.pm = fm + ((wgid % nig) % gsz); u.pn = (wgid % nig) / gsz; return true;
    }
    __device__ __forceinline__ void a_ready(const Unit&) const {}
    __device__ __forceinline__ void done(const Unit&) const {}
};

struct PanelOrder {
    int mode, c;
    __device__ __forceinline__ bool next(int i, Unit& u) const {
        const int xcd = c & 7, slot = c >> 3;
        if (mode == 0) { if (i >= 2) return false; u.pm = i * 64 + xcd * 8 + (slot >> 2); u.pn = slot & 3; return true; }
        if (i >= 1 || c < 0 || c >= 64) return false;
        u.pm = 128 + xcd * 2 + (slot >> 2); u.pn = slot & 3; return true;
    }
    __device__ __forceinline__ void a_ready(const Unit&) const {}
    __device__ __forceinline__ void done(const Unit&) const {}
};

__device__ __forceinline__ unsigned cvt_pk_bf16(float lo, float hi) { unsigned r; asm volatile("v_cvt_pk_bf16_f32 %0, %1, %2" : "=v"(r) : "v"(lo), "v"(hi)); return r; }

__device__ __forceinline__ float bf_lo(unsigned u) { return __uint_as_float(u << 16); }
__device__ __forceinline__ float bf_hi(unsigned u) { return __uint_as_float(u & 0xffff0000u); }
__device__ __forceinline__ float fsilu(float v) { return v * __builtin_amdgcn_rcpf(1.0f + fexp(-v)); }
__device__ __forceinline__ float fsigm(float v) { return __builtin_amdgcn_rcpf(1.0f + fexp(-v)); }
__device__ __forceinline__ float softplus_f(float x) { const float e = fexp(-fabsf(x)); const float l = e < 0.0078125f ? e * (1.0f + e * (-0.5f + e * 0.33333333f)) : (__builtin_amdgcn_logf(1.0f + e) * 0.69314718056f); return fmaxf(x, 0.f) + l; }

struct EpiSwiGLU {
    static constexpr bool PERM = true, AFTER_DRAIN = false;
    bf16_t* O; int ldc;
    __device__ __forceinline__ void operator()(const f32x4 (&acc)[2][2][4][2], const Unit& u, int wr, int wc, int fr, int fq) const {
        const int row0 = u.pm * BM + wr * 64 + fr, col0 = u.pn * HALF + wc * 32 + 8 * fq;
#pragma unroll
        for (int ai = 0; ai < 2; ++ai)
#pragma unroll
            for (int m = 0; m < 4; ++m) { bf16_t* rowp = O + (size_t)(row0 + ai * HALF + m * 16) * ldc + col0;
                float v[8];
#pragma unroll
                for (int n = 0; n < 2; ++n)
#pragma unroll
                    for (int i = 0; i < 4; ++i) v[n * 4 + i] = fsilu(acc[ai][0][m][n][i]) * acc[ai][1][m][n][i];
                u32x4 w; w.x = cvt_pk_bf16(v[0], v[1]); w.y = cvt_pk_bf16(v[2], v[3]); w.z = cvt_pk_bf16(v[4], v[5]); w.w = cvt_pk_bf16(v[6], v[7]);
                *(u32x4*)rowp = w; }
    }
};
struct EpiResid {
    static constexpr bool PERM = true, AFTER_DRAIN = false;
    const bf16_t* XB; bf16_t* XO; const float* xp; const float* xs; const float* mod; int gate_off; float scale; int pm0; int use_in;
    __device__ __forceinline__ void operator()(const f32x4 (&acc)[2][2][4][2], const Unit& u, int wr, int wc, int fr, int fq) const {
        const int pmg = u.pm + pm0;
        const int mrow = pmg < 16 ? 0 : 1 + ((pmg - 16) >> 4);
        const float* gate = mod + (size_t)mrow * 9216 + gate_off;
        const int col0 = u.pn * BM + wc * 32 + 8 * fq;
        const unsigned e0 = (unsigned)((wr * 64 + fr) * 1024 + col0);
        char* db = (char*)(XO + (size_t)pmg * 256 * 1024);
        if (use_in) {
            const char* sb = (const char*)(pmg < 16 ? xp + (size_t)pmg * 256 * 1024 : xs + (size_t)(pmg - 16) * 256 * 1024);
#pragma unroll
            for (int bj = 0; bj < 2; ++bj) {
                const f32x4 g0 = *(const f32x4*)(gate + col0 + bj * HALF) * scale, g1 = *(const f32x4*)(gate + col0 + bj * HALF + 4) * scale;
#pragma unroll
                for (int ai = 0; ai < 2; ++ai)
#pragma unroll
                  for (int mh = 0; mh < 4; mh += 2) {
                    f32x4 r0[2], r1[2];
                    unsigned eb = e0 + (unsigned)((ai * HALF + mh * 16) * 1024 + bj * HALF); asm volatile("" : "+v"(eb));
#pragma unroll
                    for (int m = 0; m < 2; ++m) { const unsigned e = eb + (unsigned)(m * 16 * 1024); r0[m] = *(const f32x4*)(sb + e * 4u); r1[m] = *(const f32x4*)(sb + e * 4u + 16u); }
#pragma unroll
                    for (int m = 0; m < 2; ++m) { const unsigned e = eb + (unsigned)(m * 16 * 1024);
                        const f32x4 v0 = r0[m] + g0 * acc[ai][bj][mh + m][0], v1 = r1[m] + g1 * acc[ai][bj][mh + m][1];
                        u32x4 w; w.x = cvt_pk_bf16(v0[0], v0[1]); w.y = cvt_pk_bf16(v0[2], v0[3]); w.z = cvt_pk_bf16(v1[0], v1[1]); w.w = cvt_pk_bf16(v1[2], v1[3]);
                        *(u32x4*)(db + e * 2u) = w; }
                    asm volatile("" ::: "memory");
                  }
            }
        } else {
            const char* sb = (const char*)(XB + (size_t)pmg * 256 * 1024);
#pragma unroll
            for (int bj = 0; bj < 2; ++bj) {
                const f32x4 g0 = *(const f32x4*)(gate + col0 + bj * HALF) * scale, g1 = *(const f32x4*)(gate + col0 + bj * HALF + 4) * scale;
                {
                    u32x4 r[2][4];
                    unsigned eb = e0 + (unsigned)(bj * HALF); asm volatile("" : "+v"(eb));
#pragma unroll
                    for (int ai = 0; ai < 2; ++ai)
#pragma unroll
                    for (int m = 0; m < 4; ++m) { const unsigned e = eb + (unsigned)((ai * HALF + m * 16) * 1024); r[ai][m] = *(const u32x4*)(sb + e * 2u); }
#pragma unroll
                    for (int ai = 0; ai < 2; ++ai)
#pragma unroll
                    for (int m = 0; m < 4; ++m) { const unsigned e = eb + (unsigned)((ai * HALF + m * 16) * 1024);
                        const u32x4 q = r[ai][m]; const f32x4 a0 = acc[ai][bj][m][0], a1 = acc[ai][bj][m][1];
                        u32x4 w;
                        w.x = cvt_pk_bf16(bf_lo(q.x) + g0[0] * a0[0], bf_hi(q.x) + g0[1] * a0[1]); w.y = cvt_pk_bf16(bf_lo(q.y) + g0[2] * a0[2], bf_hi(q.y) + g0[3] * a0[3]);
                        w.z = cvt_pk_bf16(bf_lo(q.z) + g1[0] * a1[0], bf_hi(q.z) + g1[1] * a1[1]); w.w = cvt_pk_bf16(bf_lo(q.w) + g1[2] * a1[2], bf_hi(q.w) + g1[3] * a1[3]);
                        *(u32x4*)(db + e * 2u) = w; }
                    asm volatile("" ::: "memory");
                }
            }
        }
    }
};
struct EpiDelta {
    static constexpr bool PERM = true, AFTER_DRAIN = false;
    bf16_t* D2; const float* mod; int gate_off; float scale;
    __device__ __forceinline__ void operator()(const f32x4 (&acc)[2][2][4][2], const Unit& u, int wr, int wc, int fr, int fq) const {
        const int mrow = u.pm < 16 ? 0 : 1 + ((u.pm - 16) >> 4);
        const float* gate = mod + (size_t)mrow * 9216 + gate_off;
        const int row0 = (u.pm - 128) * BM + wr * 64 + fr, col0 = u.pn * BM + wc * 32 + 8 * fq;
#pragma unroll
        for (int bj = 0; bj < 2; ++bj) {
            const f32x4 g0 = *(const f32x4*)(gate + col0 + bj * HALF) * scale, g1 = *(const f32x4*)(gate + col0 + bj * HALF + 4) * scale;
#pragma unroll
            for (int ai = 0; ai < 2; ++ai)
#pragma unroll
                for (int m = 0; m < 4; ++m) { const f32x4 v0 = acc[ai][bj][m][0] * g0, v1 = acc[ai][bj][m][1] * g1;
                    u32x4 w; w.x = cvt_pk_bf16(v0[0], v0[1]); w.y = cvt_pk_bf16(v0[2], v0[3]); w.z = cvt_pk_bf16(v1[0], v1[1]); w.w = cvt_pk_bf16(v1[2], v1[3]);
                    *(u32x4*)(D2 + (size_t)(row0 + ai * HALF + m * 16) * 1024 + col0 + bj * HALF) = w; }
        }
    }
};
struct EpiYZ {
    static constexpr bool PERM = true, AFTER_DRAIN = false;
    bf16_t* Y; int ldc; float* rowss;
    __device__ __forceinline__ void operator()(const f32x4 (&acc)[2][2][4][2], const Unit& u, int wr, int wc, int fr, int fq) const {
        const int row0 = u.pm * BM + wr * 64 + fr, col0 = u.pn * BM + wc * 32 + 8 * fq;
#pragma unroll
        for (int ai = 0; ai < 2; ++ai) {
            float ss[4] = {0.f, 0.f, 0.f, 0.f};
            unsigned eb = (unsigned)((row0 + ai * HALF) * ldc + col0); asm volatile("" : "+v"(eb));
            u32x4 yq[2][4];
#pragma unroll
            for (int bj = 0; bj < 2; ++bj)
#pragma unroll
                for (int m = 0; m < 4; ++m) yq[bj][m] = *(const u32x4*)((const char*)Y + ((size_t)eb + (size_t)(m * 16 * ldc + bj * HALF)) * 2u);
#pragma unroll
            for (int bj = 0; bj < 2; ++bj) {
#pragma unroll
                for (int m = 0; m < 4; ++m) { const f32x4 a0 = acc[ai][bj][m][0], a1 = acc[ai][bj][m][1]; const u32x4 q = yq[bj][m];
                    const float v0 = bf_lo(q.x) * fsilu(a0[0]), v1 = bf_hi(q.x) * fsilu(a0[1]), v2 = bf_lo(q.y) * fsilu(a0[2]), v3 = bf_hi(q.y) * fsilu(a0[3]);
                    const float v4 = bf_lo(q.z) * fsilu(a1[0]), v5 = bf_hi(q.z) * fsilu(a1[1]), v6 = bf_lo(q.w) * fsilu(a1[2]), v7 = bf_hi(q.w) * fsilu(a1[3]);
                    ss[m] += (v0 * v0 + v1 * v1) + (v2 * v2 + v3 * v3) + (v4 * v4 + v5 * v5) + (v6 * v6 + v7 * v7);
                    u32x4 w; w.x = cvt_pk_bf16(v0, v1); w.y = cvt_pk_bf16(v2, v3); w.z = cvt_pk_bf16(v4, v5); w.w = cvt_pk_bf16(v6, v7);
                    *(u32x4*)((char*)Y + ((size_t)eb + (size_t)(m * 16 * ldc + bj * HALF)) * 2u) = w; }
                asm volatile("" ::: "memory");
            }
#pragma unroll
            for (int m = 0; m < 4; ++m) { float s = ss[m]; s += __shfl_xor(s, 16); s += __shfl_xor(s, 32);
                if (fq == 0) atomicAdd(rowss + row0 + ai * HALF + m * 16, s); }
        }
    }
};
struct EpiStore {
    static constexpr bool PERM = true, AFTER_DRAIN = false;
    bf16_t* O; int ldc; int dt_pn; float* DT; const float* dtb; int split_pn; size_t split_stride;
    __device__ __forceinline__ void operator()(const f32x4 (&acc)[2][2][4][2], const Unit& u, int wr, int wc, int fr, int fq) const {
        const int row0 = u.pm * BM + wr * 64 + fr;
        if (u.pn == dt_pn) {
            if (wc < 2) {
                const int c0 = wc * 32 + 8 * fq;
                f32x4 b0 = *(const f32x4*)(dtb + c0), b1 = *(const f32x4*)(dtb + c0 + 4);
#pragma unroll
                for (int ai = 0; ai < 2; ++ai)
#pragma unroll
                    for (int m = 0; m < 4; ++m) { float* rowp = DT + (size_t)(row0 + ai * HALF + m * 16) * 64 + c0;
                        f32x4 v0 = acc[ai][0][m][0] + b0, v1 = acc[ai][0][m][1] + b1;
#pragma unroll
                        for (int i = 0; i < 4; ++i) { v0[i] = softplus_f(v0[i]); v1[i] = softplus_f(v1[i]); }
                        *(f32x4*)rowp = v0; *(f32x4*)(rowp + 4) = v1; }
            }
            return;
        }
        int pnl = u.pn; bf16_t* base = O;
        if (split_pn > 0) { const int t = u.pn / split_pn; pnl = u.pn - t * split_pn; base = O + (size_t)t * split_stride; }
        const int col0 = pnl * BM + wc * 32 + 8 * fq;
#pragma unroll
        for (int ai = 0; ai < 2; ++ai)
#pragma unroll
            for (int m = 0; m < 4; ++m) { bf16_t* rowp = base + (size_t)(row0 + ai * HALF + m * 16) * ldc + col0;
#pragma unroll
                for (int bj = 0; bj < 2; ++bj) { const f32x4 v0 = acc[ai][bj][m][0], v1 = acc[ai][bj][m][1];
                    u32x4 w; w.x = cvt_pk_bf16(v0[0], v0[1]); w.y = cvt_pk_bf16(v0[2], v0[3]); w.z = cvt_pk_bf16(v1[0], v1[1]); w.w = cvt_pk_bf16(v1[2], v1[3]);
                    *(u32x4*)(rowp + bj * HALF) = w; } }
    }
};
template <int MODE> struct EpiGate {
    static constexpr bool PERM = true, AFTER_DRAIN = false;
    static constexpr int MB = 4;
    bf16_t* O; int ldc; const float* cs; const bf16_t* G; int ldg; const float* rowss;
    __device__ __forceinline__ void operator()(const f32x4 (&acc)[2][2][4][2], const Unit& u, int wr, int wc, int fr, int fq) const {
        const int row0 = u.pm * BM + wr * 64 + fr, col0 = u.pn * BM + wc * 32 + 8 * fq;
#pragma unroll
        for (int bj = 0; bj < 2; ++bj) {
            f32x4 s0 = (f32x4){1.f, 1.f, 1.f, 1.f}, s1 = s0;
            if (MODE == 0) { s0 = *(const f32x4*)(cs + col0 + bj * HALF); s1 = *(const f32x4*)(cs + col0 + bj * HALF + 4); }
#pragma unroll
            for (int ai = 0; ai < 2; ++ai)
#pragma unroll
              for (int mh = 0; mh < 4; mh += MB) {
                u32x4 gq[4], oq[4]; float rsv[4] = {1.f, 1.f, 1.f, 1.f};
                if (MODE != 0) {
#pragma unroll
                    for (int m = mh; m < mh + MB; ++m) { const int row = row0 + ai * HALF + m * 16;
                        if (MODE == 3) rsv[m] = rowss[row];
                        gq[m] = *(const u32x4*)(G + (size_t)row * ldg + col0 + bj * HALF);
                        if (MODE == 2) oq[m] = *(const u32x4*)(O + (size_t)row * ldc + col0 + bj * HALF); }
                }
#pragma unroll
                for (int m = mh; m < mh + MB; ++m) { const int row = row0 + ai * HALF + m * 16; bf16_t* rowp = O + (size_t)row * ldc + col0 + bj * HALF;
                    const f32x4 a0 = acc[ai][bj][m][0], a1 = acc[ai][bj][m][1];
                    float v[8] = {a0[0], a0[1], a0[2], a0[3], a1[0], a1[1], a1[2], a1[3]};
                    if (MODE == 0) {
#pragma unroll
                        for (int i = 0; i < 4; ++i) { v[i] *= s0[i]; v[4 + i] *= s1[i]; } }
                    else { const unsigned gw[4] = {gq[m].x, gq[m].y, gq[m].z, gq[m].w};
                        const float rr = (MODE == 3) ? __builtin_amdgcn_rsqf((rsv[m] + 2048.0f * 1e-6f) * (1.0f / 2048.0f)) : 1.0f;
#pragma unroll
                        for (int i = 0; i < 4; ++i) { v[2 * i] *= fsigm(bf_lo(gw[i])) * rr; v[2 * i + 1] *= fsigm(bf_hi(gw[i])) * rr; }
                        if (MODE == 2) { const unsigned ow[4] = {oq[m].x, oq[m].y, oq[m].z, oq[m].w};
#pragma unroll
                            for (int i = 0; i < 4; ++i) { v[2 * i] += bf_lo(ow[i]); v[2 * i + 1] += bf_hi(ow[i]); } } }
                    u32x4 w; w.x = cvt_pk_bf16(v[0], v[1]); w.y = cvt_pk_bf16(v[2], v[3]); w.z = cvt_pk_bf16(v[4], v[5]); w.w = cvt_pk_bf16(v[6], v[7]);
                    *(u32x4*)rowp = w; }
                asm volatile("" ::: "memory");
            }
        }
    }
};

template <class Epi, class Sched>
__device__ __forceinline__ void gemm_phase(PG8_LAS unsigned char* lds_in, const Gemm g, const Sched& S, const Epi& E) {
    PG8_LAS unsigned char* lds = lds_in; { unsigned z_ = 0; asm volatile("" : "+s"(z_)); lds += z_; }
    int tid_ = threadIdx.x; asm volatile("" : "+v"(tid_));
    const int tid = tid_, wid = __builtin_amdgcn_readfirstlane(tid >> 6), lane = tid & 63, wr = wid >> 2, wc = wid & 3, fr = lane & 15, fq = lane >> 4;
    const int K = g.K, nt = K / BK, lda = g.lda, ldb = g.ldb;
    unsigned voffA[2], voffB[2];
#pragma unroll
    for (int i = 0; i < 2; ++i) { int R, C; stage_rc(tid * 16 + i * 8192, R, C); const int Rb = Epi::PERM ? ((R & ~31) + perm32(R & 31)) : R;
        voffA[i] = (unsigned)(R * lda + C) * 2u; voffB[i] = (unsigned)(Rb * ldb + C) * 2u; }
    const size_t kstep = (size_t)(BK * 2);
    const size_t hstepA = (size_t)HALF * lda * 2, hstepB = (size_t)HALF * ldb * 2, acol = (size_t)g.a_pn_bytes;
    const size_t tstepA = 2 * hstepA, tstepB = 2 * hstepB;
    const unsigned ldsw = (unsigned)wid * 1024u;
    const int aoff = lds_byte(wr * 64 + fr, fq * 8), boff = lds_byte(wc * 32 + fr, fq * 8);
#define PG8_SA(b, h) (((b) * 2 + (h)) * HTB)
#define PG8_SB(b, h) ((4 + (b) * 2 + (h)) * HTB)
#define PG8_STAGE(bufoff, gbase, voff) do { _Pragma("unroll") for (int _i = 0; _i < 2; ++_i) \
        __builtin_amdgcn_global_load_lds((const unsigned*)((const char*)(gbase) + (voff)[_i]), (PG8_LAS unsigned*)(lds + (bufoff) + ldsw + _i * 8192), 16, 0, 0); } while (0)
#define PG8_LDA(dst, b, h) do { _Pragma("unroll") for (int m = 0; m < 4; ++m) _Pragma("unroll") for (int k = 0; k < 2; ++k) dst[m][k] = *(const PG8_LAS bf16x8*)(lds + PG8_SA(b, h) + aoff + m * 2048 + k * 1024); } while (0)
#define PG8_LDB(dst, b, h) do { _Pragma("unroll") for (int n = 0; n < 2; ++n) _Pragma("unroll") for (int k = 0; k < 2; ++k) dst[n][k] = *(const PG8_LAS bf16x8*)(lds + PG8_SB(b, h) + boff + n * 2048 + k * 1024); } while (0)
#define PG8_MMA(ai, bj, At, Bt) do { __builtin_amdgcn_s_setprio(1); _Pragma("unroll") for (int m = 0; m < 4; ++m) _Pragma("unroll") for (int n = 0; n < 2; ++n) _Pragma("unroll") for (int k = 0; k < 2; ++k) \
        acc[ai][bj][m][n] = __builtin_amdgcn_mfma_f32_16x16x32_bf16(Bt[n][k], At[m][k], acc[ai][bj][m][n], 0, 0, 0); __builtin_amdgcn_s_setprio(0); } while (0)
#define PG8_WAIT_V(n) asm volatile("s_waitcnt vmcnt(" #n ")" ::: "memory")
#define PG8_WAIT_L(n) asm volatile("s_waitcnt lgkmcnt(" #n ")" ::: "memory")
#define PG8_BAR __builtin_amdgcn_s_barrier()
#define PG8_SCHED __builtin_amdgcn_sched_barrier(0)
    Unit cur, nxt; int ui = 0;
    if (!S.next(0, cur)) return;
    f32x4 acc[2][2][4][2];
#pragma unroll
    for (int a = 0; a < 2; ++a)
#pragma unroll
        for (int b = 0; b < 2; ++b)
#pragma unroll
            for (int m = 0; m < 4; ++m)
#pragma unroll
                for (int n = 0; n < 2; ++n) acc[a][b][m][n] = (f32x4){0.f, 0.f, 0.f, 0.f};
    bf16x8 At[4][2], B0[2][2], B1[2][2];
    const char* cA = (const char*)g.A + (size_t)cur.pm * tstepA + (size_t)cur.pn * acol; const char* cB = (const char*)g.Bt + (size_t)cur.pn * tstepB;
    S.a_ready(cur);
    PG8_STAGE(PG8_SB(0, 0), cB, voffB); PG8_STAGE(PG8_SA(0, 0), cA, voffA); PG8_STAGE(PG8_SB(0, 1), cB + hstepB, voffB); PG8_STAGE(PG8_SA(0, 1), cA + hstepA, voffA);
    if (wr == 1) PG8_BAR;
    PG8_WAIT_V(4); PG8_BAR;
    PG8_STAGE(PG8_SB(1, 0), cB + kstep, voffB); PG8_STAGE(PG8_SA(1, 0), cA + kstep, voffA); PG8_STAGE(PG8_SB(1, 1), cB + hstepB + kstep, voffB);
    PG8_WAIT_V(6); PG8_BAR;
    for (;;) {
        const bool has_next = S.next(ui + 1, nxt);
        const char* nA = has_next ? (const char*)g.A + (size_t)nxt.pm * tstepA + (size_t)nxt.pn * acol : cA; const char* nB = has_next ? (const char*)g.Bt + (size_t)nxt.pn * tstepB : cB;
        for (int t = 0; t < nt; t += 2) {
            const bool last = (t == nt - 2);
            const char* a1 = cA + (size_t)(t + 1) * kstep;
            const char* a2 = last ? nA : cA + (size_t)(t + 2) * kstep; const char* b2 = last ? nB : cB + (size_t)(t + 2) * kstep;
            const char* a3 = a2 + kstep; const char* b3 = b2 + kstep;
            if (last && has_next) S.a_ready(nxt);
            PG8_LDB(B0, 0, 0); PG8_SCHED; PG8_LDA(At, 0, 0); PG8_STAGE(PG8_SA(1, 1), a1 + hstepA, voffA);
            PG8_WAIT_L(8); PG8_BAR; PG8_WAIT_L(0); PG8_MMA(0, 0, At, B0); PG8_BAR; PG8_SCHED;
            PG8_LDB(B1, 0, 1); PG8_STAGE(PG8_SB(0, 0), b2, voffB);
            PG8_BAR; PG8_WAIT_L(0); PG8_MMA(0, 1, At, B1); PG8_BAR;
            PG8_LDA(At, 0, 1); PG8_STAGE(PG8_SA(0, 0), a2, voffA);
            PG8_BAR; PG8_WAIT_L(0); PG8_MMA(1, 0, At, B0); PG8_BAR; PG8_SCHED;
            PG8_STAGE(PG8_SB(0, 1), b2 + hstepB, voffB);
            PG8_WAIT_V(6); PG8_BAR; PG8_MMA(1, 1, At, B1); PG8_BAR;
            PG8_LDB(B0, 1, 0); PG8_SCHED; PG8_LDA(At, 1, 0); PG8_STAGE(PG8_SA(0, 1), a2 + hstepA, voffA);
            PG8_WAIT_L(8); PG8_BAR; PG8_WAIT_L(0); PG8_MMA(0, 0, At, B0); PG8_BAR; PG8_SCHED;
            PG8_LDB(B1, 1, 1); PG8_STAGE(PG8_SB(1, 0), b3, voffB);
            PG8_BAR; PG8_WAIT_L(0); PG8_MMA(0, 1, At, B1); PG8_BAR;
            PG8_LDA(At, 1, 1); PG8_STAGE(PG8_SA(1, 0), a3, voffA);
            PG8_BAR; PG8_WAIT_L(0); PG8_MMA(1, 0, At, B0); PG8_BAR; PG8_SCHED;
            PG8_STAGE(PG8_SB(1, 1), b3 + hstepB, voffB);
            PG8_WAIT_V(6); PG8_BAR; PG8_MMA(1, 1, At, B1); PG8_BAR;
        }
        if constexpr (!Epi::AFTER_DRAIN) { E(acc, cur, wr, wc, fr, fq); S.done(cur); }
        if (!has_next) break;
#pragma unroll
        for (int a = 0; a < 2; ++a)
#pragma unroll
            for (int b = 0; b < 2; ++b)
#pragma unroll
                for (int m = 0; m < 4; ++m)
#pragma unroll
                    for (int n = 0; n < 2; ++n) acc[a][b][m][n] = (f32x4){0.f, 0.f, 0.f, 0.f};
        cur = nxt; cA = nA; cB = nB; ++ui;
    }
    PG8_WAIT_V(0);
    if (wr == 0) PG8_BAR;
    PG8_BAR;
    if constexpr (Epi::AFTER_DRAIN) { E.fused(acc, cur, wr, wc, fr, fq, lds, wid, lane); S.done(cur); }
#undef PG8_SA
#undef PG8_SB
#undef PG8_STAGE
#undef PG8_LDA
#undef PG8_LDB
#undef PG8_MMA
#undef PG8_WAIT_V
#undef PG8_WAIT_L
#undef PG8_BAR
#undef PG8_SCHED
}
}

namespace cg = cooperative_groups;
using pg8::fexp;
#define LAS __attribute__((address_space(3)))
typedef unsigned short bf16;
typedef short bf16x8 __attribute__((ext_vector_type(8)));
typedef short s16x4 __attribute__((ext_vector_type(4)));
typedef float f32x4 __attribute__((ext_vector_type(4)));
typedef unsigned u32x4 __attribute__((ext_vector_type(4)));
typedef unsigned u32x2 __attribute__((ext_vector_type(2)));

constexpr int DM = 1024, T_CTX = 4096, T_LAT = 32768, T_ALL = T_CTX + T_LAT, DFF = 2816, DIN = 2048, CONVD = 3072, NHEAD = 32;
constexpr int NWAVES = 8, NTHR = 512;
constexpr int LDS_BYTES = 131072 + 256;
constexpr size_t WS_BAR = 768 * 1024, BAR_ZERO_BYTES = 16384;
constexpr size_t WS_ROWSS = 800 * 1024;
constexpr float EPS = 1e-6f;
constexpr size_t MiB = 1u << 20;
constexpr size_t WS_MOD = 0;
constexpr size_t WS_W = 1 * MiB;
constexpr size_t WO_W13A = 0, WO_W2A = 11534336, WO_W13B = 17301504, WO_W2B = 28835840, WO_WINA = 34603008, WO_WINB = 41418752, WO_PW = 51904512, WO_WBP = 52428800, WO_WBS = 54525952, WO_WO = 58720256;
constexpr size_t WS_H = 60 * MiB, WS_RA = 132 * MiB, WS_RB = 348 * MiB, WS_DT = 492 * MiB, WS_D2 = 501 * MiB, WS_END = 509 * MiB;
constexpr int NA_ROWS = 3328, NB_ROWS = 5120;
constexpr size_t RA_Z = 0, RA_U = 0, RA_GA = 72 * MiB, RA_GB = 144 * MiB, RA_MG = RA_U;
constexpr size_t RA_XH = 0, RA_BG = (size_t)32 * 36864 * 64 * 2, RA_CG = RA_BG + (size_t)4 * 36864 * 128 * 2;
constexpr size_t OUT_SF = (size_t)T_ALL * DM, OUT_SB = OUT_SF + 16 * 2 * 32 * 64 * 128;

__device__ __forceinline__ unsigned f2bf(float f) { unsigned u = __float_as_uint(f); return (u + 0x7fffu + ((u >> 16) & 1u)) >> 16; }
__device__ __forceinline__ unsigned pk2(float lo, float hi) { return pg8::cvt_pk_bf16(lo, hi); }
__device__ __forceinline__ float blo(unsigned u) { return __uint_as_float(u << 16); }
__device__ __forceinline__ float bhi(unsigned u) { return __uint_as_float(u & 0xffff0000u); }
__device__ __forceinline__ float wave_sum(float v) {
#pragma unroll
    for (int o = 1; o < 64; o <<= 1) v += __shfl_xor(v, o);
    return v;
}
__device__ __forceinline__ float silu_f(float v) { return v * __builtin_amdgcn_rcpf(1.0f + fexp(-v)); }

struct Args {
    const float* in[26];
    float* out; unsigned char* ws;
};

__device__ __forceinline__ void transpose_item(const float* W, int ldw, int K, bf16* WT, int n0, int c0, int k0, LAS float* scr, int lane, const float* kscale = nullptr) {
    const int c = lane & 7;
    if (c0 < 0) {
#pragma unroll
        for (int j = 0; j < 4; ++j) { const int n = (lane >> 3) + 8 * j; *(u32x4*)(WT + (size_t)(n0 + n) * K + k0 + 8 * c) = (u32x4){0u, 0u, 0u, 0u}; }
        return;
    }
    float wv[32];
#pragma unroll
    for (int i = 0; i < 32; ++i) { const int kk = 2 * i + (lane >> 5); wv[i] = W[(size_t)(k0 + kk) * ldw + c0 + (lane & 31)]; if (kscale) wv[i] *= kscale[k0 + kk]; }
#pragma unroll
    for (int i = 0; i < 32; ++i) { const int kk = 2 * i + (lane >> 5); scr[kk * 33 + (lane & 31)] = wv[i]; }
    asm volatile("s_waitcnt lgkmcnt(0)" ::: "memory");
#pragma unroll
    for (int j = 0; j < 4; ++j) { const int n = (lane >> 3) + 8 * j; const LAS float* s = scr + (8 * c) * 33 + n;
        u32x4 o; o.x = pk2(s[0 * 33], s[1 * 33]); o.y = pk2(s[2 * 33], s[3 * 33]); o.z = pk2(s[4 * 33], s[5 * 33]); o.w = pk2(s[6 * 33], s[7 * 33]);
        *(u32x4*)(WT + (size_t)(n0 + n) * K + k0 + 8 * c) = o; }
    asm volatile("s_waitcnt lgkmcnt(0)" ::: "memory");
}
__device__ __forceinline__ void convert_phase(const Args& a, int l, LAS unsigned char* lds, int gw, int ngw, int wave, int lane) {
    unsigned char* wsb = a.ws; asm volatile("" : "+s"(wsb));
    { unsigned z_ = 0; asm volatile("" : "+s"(z_)); lds += z_; }
    LAS float* scr = (LAS float*)(lds + wave * 8448);
    unsigned char* wb = wsb + WS_W;
    constexpr int I13 = 16 * 176, I2 = 44 * 32, IA = 16 * 104, IB = 16 * 160, IPW = 128, IBP = 16 * 32, IBS = 32 * 32, IWO = 16 * 32;
    constexpr int NITEMS = 2 * I13 + 2 * I2 + IA + IB + IPW + IBP + IBS + IWO;
    for (int it = gw; it < NITEMS; it += ngw) {
        int r = it;
        if (r < 2 * I13) { const int which = r / I13; r -= which * I13; const int kb = r / 176, nb = r % 176, n0 = nb * 32, tile = n0 >> 8, j0 = n0 & 255;
            const int c0 = j0 < 128 ? 128 * tile + j0 : DFF + 128 * tile + (j0 - 128);
            transpose_item(a.in[which ? 11 : 9] + (size_t)l * DM * 2 * DFF, 2 * DFF, DM, (bf16*)(wb + (which ? WO_W13B : WO_W13A)), n0, c0, kb * 64, scr, lane); continue; }
        r -= 2 * I13;
        if (r < 2 * I2) { const int which = r / I2; r -= which * I2; const int kb = r / 32, nb = r % 32;
            transpose_item(a.in[which ? 12 : 10] + (size_t)l * DFF * DM, DM, DFF, (bf16*)(wb + (which ? WO_W2B : WO_W2A)), nb * 32, nb * 32, kb * 64, scr, lane); continue; }
        r -= 2 * I2;
        const float* win = a.in[13] + (size_t)l * DM * 8256;
        if (r < IA) { const int kb = r / 104, nb = r % 104, n0 = nb * 32; const int c0 = n0 < 3136 ? 3072 + n0 : -1;
            transpose_item(win, 8256, DM, (bf16*)(wb + WO_WINA), n0, c0, kb * 64, scr, lane); continue; }
        r -= IA;
        if (r < IB) { const int kb = r / 160, nb = r % 160, n0 = nb * 32; const int c0 = n0 < 2048 ? 1024 + n0 : (n0 < 3072 ? n0 - 2048 : n0 + 3136);
            transpose_item(win, 8256, DM, (bf16*)(wb + WO_WINB), n0, c0, kb * 64, scr, lane); continue; }
        r -= IB;
        if (r < IPW) { const int g = r / 32; r -= g * 32; const int kb = r / 8, nb = r % 8;
            transpose_item(a.in[14] + (size_t)(l * 4 + g) * 65536, 256, 256, (bf16*)(wb + WO_PW) + (size_t)g * 65536, nb * 32, nb * 32, kb * 64, scr, lane); continue; }
        r -= IPW;
        if (r < IBP) { const int kb = r / 32, nb = r % 32;
            transpose_item(a.in[22] + (size_t)l * DM * DM, DM, DM, (bf16*)(wb + WO_WBP), nb * 32, nb * 32, kb * 64, scr, lane); continue; }
        r -= IBP;
        if (r < IBS) { const int kb = r / 32, nb = r % 32;
            transpose_item(a.in[23] + (size_t)l * DIN * DM, DM, DIN, (bf16*)(wb + WO_WBS), nb * 32, nb * 32, kb * 64, scr, lane, a.in[21] + (size_t)l * DIN); continue; }
        r -= IBS;
        { const int kb = r / 32, nb = r % 32;
            transpose_item(a.in[24] + (size_t)l * DM * DM, DM, DM, (bf16*)(wb + WO_WO), nb * 32, nb * 32, kb * 64, scr, lane); }
    }
}
__device__ __forceinline__ void adaln_phase(const Args& a, LAS unsigned char* lds, int tid) {
    unsigned char* wsb = a.ws; asm volatile("" : "+s"(wsb));
    { unsigned z_ = 0; asm volatile("" : "+s"(z_)); lds += z_; }
    LAS float* sc = (LAS float*)lds;
    LAS float* red = (LAS float*)(lds + 36864);
    float* MOD = (float*)(wsb + WS_MOD);
    if ((int)blockIdx.x >= 288) return;
    for (int i = tid; i < 9 * 1024; i += NTHR) { const int r = i >> 10, k = i & 1023; const float v = r == 0 ? a.in[5][k] : a.in[4][(r - 1) * 1024 + k]; sc[i] = silu_f(v); }
    __syncthreads();
    const int cgp = tid & 15, kc = tid >> 4;
    for (int item = blockIdx.x; item < 288; item += gridDim.x) {
        const int l = item / 144, cgi = item % 144, col0 = cgi * 64 + 4 * cgp;
        const float* w = a.in[6] + ((size_t)l * 1024 + kc * 32) * 9216 + col0;
        f32x4 acc[9];
#pragma unroll
        for (int r = 0; r < 9; ++r) acc[r] = (f32x4){0.f, 0.f, 0.f, 0.f};
#pragma unroll 16
        for (int i = 0; i < 32; ++i) { const f32x4 w4 = *(const f32x4*)(w + (size_t)i * 9216);
#pragma unroll
            for (int r = 0; r < 9; ++r) acc[r] += w4 * sc[r * 1024 + kc * 32 + i]; }
#pragma unroll
        for (int r = 0; r < 9; ++r) *(LAS f32x4*)(red + (kc * 9 + r) * 64 + 4 * cgp) = acc[r];
        __syncthreads();
        for (int o = tid; o < 576; o += NTHR) { const int r = o >> 6, c = o & 63; float s = 0.f;
#pragma unroll 8
            for (int k = 0; k < 32; ++k) s += red[(k * 9 + r) * 64 + c];
            MOD[((size_t)l * 9 + r) * 9216 + cgi * 64 + c] = s + a.in[7][(size_t)l * 9216 + cgi * 64 + c]; }
        __syncthreads();
    }
}
__device__ __forceinline__ void normmod_phase(const Args& a, int l, int idx, bool use_in, bool has_d2, int gw, int ngw, int lane) {
    unsigned char* wsb = a.ws; asm volatile("" : "+s"(wsb));
    const float* MOD = (const float*)(wsb + WS_MOD) + (size_t)l * 9 * 9216;
    bf16* XB = (bf16*)a.out; bf16* H = (bf16*)(wsb + WS_H); const bf16* D2 = (const bf16*)(wsb + WS_D2);
    const float* gp = a.in[8] + ((size_t)l * 3 + idx) * DM;
    f32x4 gv[2][2];
#pragma unroll
    for (int j = 0; j < 2; ++j) { gv[j][0] = *(const f32x4*)(gp + 8 * (lane + 64 * j)); gv[j][1] = *(const f32x4*)(gp + 8 * (lane + 64 * j) + 4); }
    constexpr int R = 3;
    const int rpw = (((T_ALL + ngw - 1) / ngw + R - 1) / R) * R;
    const int rbeg = gw * rpw, rend = min(rbeg + rpw, T_ALL);
    int cur_mrow = -1; f32x4 gsc[2][2], shv[2][2];
#pragma unroll
    for (int j = 0; j < 2; ++j) { gsc[j][0] = gv[j][0]; gsc[j][1] = gv[j][1]; shv[j][0] = gv[j][0]; shv[j][1] = gv[j][1]; }
    for (int r0 = rbeg; r0 < rend; r0 += R) {
        f32x4 v[R][2][2]; float s[R];
        if (use_in) {
#pragma unroll
            for (int r = 0; r < R; ++r) { const int row = r0 + r;
                const float* srcp = row < T_CTX ? a.in[0] + (size_t)row * DM : a.in[1] + (size_t)(row - T_CTX) * DM;
#pragma unroll
                for (int j = 0; j < 2; ++j) { v[r][j][0] = *(const f32x4*)(srcp + 8 * (lane + 64 * j)); v[r][j][1] = *(const f32x4*)(srcp + 8 * (lane + 64 * j) + 4); } }
        } else {
            u32x4 q[R][2];
#pragma unroll
            for (int r = 0; r < R; ++r)
#pragma unroll
                for (int j = 0; j < 2; ++j) q[r][j] = *(const u32x4*)(XB + (size_t)(r0 + r) * DM + 8 * (lane + 64 * j));
#pragma unroll
            for (int r = 0; r < R; ++r)
#pragma unroll
                for (int j = 0; j < 2; ++j) { v[r][j][0] = (f32x4){blo(q[r][j].x), bhi(q[r][j].x), blo(q[r][j].y), bhi(q[r][j].y)}; v[r][j][1] = (f32x4){blo(q[r][j].z), bhi(q[r][j].z), blo(q[r][j].w), bhi(q[r][j].w)}; }
            if (has_d2 && r0 + R - 1 >= 32768) {
#pragma unroll
                for (int r = 0; r < R; ++r) { const int row = r0 + r;
                    if (row >= 32768) {
#pragma unroll
                        for (int j = 0; j < 2; ++j) { const u32x4 d = *(const u32x4*)(D2 + (size_t)(row - 32768) * DM + 8 * (lane + 64 * j));
                            v[r][j][0] += (f32x4){blo(d.x), bhi(d.x), blo(d.y), bhi(d.y)}; v[r][j][1] += (f32x4){blo(d.z), bhi(d.z), blo(d.w), bhi(d.w)};
                            u32x4 w; w.x = pk2(v[r][j][0].x, v[r][j][0].y); w.y = pk2(v[r][j][0].z, v[r][j][0].w); w.z = pk2(v[r][j][1].x, v[r][j][1].y); w.w = pk2(v[r][j][1].z, v[r][j][1].w);
                            *(u32x4*)(XB + (size_t)row * DM + 8 * (lane + 64 * j)) = w;
                            v[r][j][0] = (f32x4){blo(w.x), bhi(w.x), blo(w.y), bhi(w.y)}; v[r][j][1] = (f32x4){blo(w.z), bhi(w.z), blo(w.w), bhi(w.w)}; } } }
            }
        }
#pragma unroll
        for (int r = 0; r < R; ++r) { s[r] = 0.f;
#pragma unroll
            for (int j = 0; j < 2; ++j)
#pragma unroll
                for (int h = 0; h < 2; ++h) s[r] += (v[r][j][h].x * v[r][j][h].x + v[r][j][h].y * v[r][j][h].y) + (v[r][j][h].z * v[r][j][h].z + v[r][j][h].w * v[r][j][h].w); }
#pragma unroll
        for (int o = 1; o < 64; o <<= 1) {
#pragma unroll
            for (int r = 0; r < R; ++r) s[r] += __shfl_xor(s[r], o); }
#pragma unroll
        for (int r = 0; r < R; ++r) { const int row = r0 + r;
            const int mrow = row < T_CTX ? 0 : 1 + ((row - T_CTX) >> 12);
            if (mrow != cur_mrow) {
                cur_mrow = mrow;
                const float* sh = MOD + (size_t)mrow * 9216 + (3 * idx) * DM;
                const float* scl = MOD + (size_t)mrow * 9216 + (3 * idx + 1) * DM;
#pragma unroll
                for (int j = 0; j < 2; ++j)
#pragma unroll
                    for (int h = 0; h < 2; ++h) { gsc[j][h] = gv[j][h] * (*(const f32x4*)(scl + 8 * (lane + 64 * j) + 4 * h) + 1.0f); shv[j][h] = *(const f32x4*)(sh + 8 * (lane + 64 * j) + 4 * h); }
            }
            const float rstd = __builtin_amdgcn_rsqf((s[r] + EPS * DM) * (1.f / DM));
#pragma unroll
            for (int j = 0; j < 2; ++j) { const f32x4 h0 = (v[r][j][0] * rstd) * gsc[j][0] + shv[j][0], h1 = (v[r][j][1] * rstd) * gsc[j][1] + shv[j][1];
                u32x4 w; w.x = pk2(h0.x, h0.y); w.y = pk2(h0.z, h0.w); w.z = pk2(h1.x, h1.y); w.w = pk2(h1.z, h1.w);
                *(u32x4*)(H + (size_t)row * DM + 8 * (lane + 64 * j)) = w; } }
    }
}
__device__ __forceinline__ void final_norm_phase(const Args& a, bool has_d2, int gw, int ngw, int lane) {
    unsigned char* wsb = a.ws; asm volatile("" : "+s"(wsb));
    float* OUT = a.out; const bf16* XW = (const bf16*)(wsb + WS_RB); const bf16* D2 = (const bf16*)(wsb + WS_D2);
    const float* gp = a.in[25];
    f32x4 gv[2][2];
#pragma unroll
    for (int j = 0; j < 2; ++j) { gv[j][0] = *(const f32x4*)(gp + 8 * (lane + 64 * j)); gv[j][1] = *(const f32x4*)(gp + 8 * (lane + 64 * j) + 4); }
    constexpr int R = 3;
    for (int r0 = gw * R; r0 < T_ALL; r0 += ngw * R) {
        u32x4 q[R][2]; f32x4 v[R][2][2]; float s[R];
#pragma unroll
        for (int r = 0; r < R; ++r)
#pragma unroll
            for (int j = 0; j < 2; ++j) q[r][j] = *(const u32x4*)(XW + (size_t)(r0 + r) * DM + 8 * (lane + 64 * j));
#pragma unroll
        for (int r = 0; r < R; ++r)
#pragma unroll
            for (int j = 0; j < 2; ++j) { v[r][j][0] = (f32x4){blo(q[r][j].x), bhi(q[r][j].x), blo(q[r][j].y), bhi(q[r][j].y)}; v[r][j][1] = (f32x4){blo(q[r][j].z), bhi(q[r][j].z), blo(q[r][j].w), bhi(q[r][j].w)}; }
        if (has_d2 && r0 + R - 1 >= 32768) {
#pragma unroll
            for (int r = 0; r < R; ++r) if (r0 + r >= 32768) {
#pragma unroll
                for (int j = 0; j < 2; ++j) { const u32x4 d = *(const u32x4*)(D2 + (size_t)(r0 + r - 32768) * DM + 8 * (lane + 64 * j));
                    v[r][j][0] += (f32x4){blo(d.x), bhi(d.x), blo(d.y), bhi(d.y)}; v[r][j][1] += (f32x4){blo(d.z), bhi(d.z), blo(d.w), bhi(d.w)}; } }
        }
#pragma unroll
        for (int r = 0; r < R; ++r) { s[r] = 0.f;
#pragma unroll
            for (int j = 0; j < 2; ++j)
#pragma unroll
                for (int h = 0; h < 2; ++h) s[r] += (v[r][j][h].x * v[r][j][h].x + v[r][j][h].y * v[r][j][h].y) + (v[r][j][h].z * v[r][j][h].z + v[r][j][h].w * v[r][j][h].w); }
#pragma unroll
        for (int o = 1; o < 64; o <<= 1) {
#pragma unroll
            for (int r = 0; r < R; ++r) s[r] += __shfl_xor(s[r], o); }
#pragma unroll
        for (int r = 0; r < R; ++r) { const float rstd = __builtin_amdgcn_rsqf((s[r] + EPS * DM) * (1.f / DM)); float* orow = OUT + (size_t)(r0 + r) * DM;
#pragma unroll
            for (int j = 0; j < 2; ++j) { *(f32x4*)(orow + 8 * (lane + 64 * j)) = v[r][j][0] * rstd * gv[j][0]; *(f32x4*)(orow + 8 * (lane + 64 * j) + 4) = v[r][j][1] * rstd * gv[j][1]; } }
    }
}
__device__ __forceinline__ void unpack8(const u32x4 q, float (&f)[8]) { f[0] = blo(q.x); f[1] = bhi(q.x); f[2] = blo(q.y); f[3] = bhi(q.y); f[4] = blo(q.z); f[5] = bhi(q.z); f[6] = blo(q.w); f[7] = bhi(q.w); }
__device__ __forceinline__ u32x4 pack8(const float (&f)[8]) { u32x4 w; w.x = pk2(f[0], f[1]); w.y = pk2(f[2], f[3]); w.z = pk2(f[4], f[5]); w.w = pk2(f[6], f[7]); return w; }
__device__ __forceinline__ void conv_phase(const Args& a, int l, int t_begin, int t_count, int raw_off, int gw, int ngw, int lane) {
    unsigned char* wsb = a.ws; asm volatile("" : "+s"(wsb));
    const bf16* RAW = (const bf16*)(wsb + WS_RB); bf16* XH = (bf16*)(wsb + WS_RA + RA_XH); bf16* BG = (bf16*)(wsb + WS_RA + RA_BG); bf16* CG = (bf16*)(wsb + WS_RA + RA_CG);
    const int nitems = (t_count / 16) * 6;
    int convd = CONVD; asm volatile("" : "+s"(convd));
    for (int it = gw; it < nitems; it += ngw) {
        const int cb = it % 6, run = it / 6, t0 = t_begin + run * 16, ch = cb * 512 + lane * 8;
        int s0, e0; if (t0 < T_CTX) { s0 = t0 & ~255; e0 = s0 + 256; } else { s0 = T_CTX + ((t0 - T_CTX) & ~4095); e0 = s0 + 4096; }
        float w[4][8], b[8];
#pragma unroll
        for (int k = 0; k < 4; ++k) { const f32x4 w0 = *(const f32x4*)(a.in[16] + ((size_t)l * 4 + k) * CONVD + ch), w1 = *(const f32x4*)(a.in[16] + ((size_t)l * 4 + k) * CONVD + ch + 4);
            w[k][0] = w0.x; w[k][1] = w0.y; w[k][2] = w0.z; w[k][3] = w0.w; w[k][4] = w1.x; w[k][5] = w1.y; w[k][6] = w1.z; w[k][7] = w1.w; }
        { const f32x4 b0 = *(const f32x4*)(a.in[17] + (size_t)l * CONVD + ch), b1 = *(const f32x4*)(a.in[17] + (size_t)l * CONVD + ch + 4);
            b[0] = b0.x; b[1] = b0.y; b[2] = b0.z; b[3] = b0.w; b[4] = b1.x; b[5] = b1.y; b[6] = b1.z; b[7] = b1.w; }
        bf16* dst; int dstride;
        if (ch < 2048) { dst = XH + (size_t)(ch >> 6) * T_ALL * 64 + (ch & 63); dstride = 64; }
        else if (ch < 2560) { dst = BG + (size_t)((ch - 2048) >> 7) * T_ALL * 128 + ((ch - 2048) & 127); dstride = 128; }
        else { dst = CG + (size_t)((ch - 2560) >> 7) * T_ALL * 128 + ((ch - 2560) & 127); dstride = 128; }
        u32x4 rw[19];
#pragma unroll
        for (int i = 0; i < 19; ++i) { const int t = t0 - 2 + i; rw[i] = (t >= s0 && t < e0) ? *(const u32x4*)(RAW + (size_t)(t - t_begin + raw_off) * convd + ch) : (u32x4){0u, 0u, 0u, 0u}; }
        float xm2[8], xm1[8], x0[8], xp1[8];
        unpack8(rw[0], xm2); unpack8(rw[1], xm1); unpack8(rw[2], x0);
#pragma unroll
        for (int i = 0; i < 16; ++i) {
            unpack8(rw[i + 3], xp1);
            float o[8];
#pragma unroll
            for (int c = 0; c < 8; ++c) { const float v = b[c] + w[0][c] * xm2[c] + w[1][c] * xm1[c] + w[2][c] * x0[c] + w[3][c] * xp1[c]; o[c] = silu_f(v); }
            *(u32x4*)(dst + (size_t)(t0 + i) * dstride) = pack8(o);
#pragma unroll
            for (int c = 0; c < 8; ++c) { xm2[c] = xm1[c]; xm1[c] = x0[c]; x0[c] = xp1[c]; }
        }
    }
}
template <int W>
__device__ __forceinline__ void hpool_g(const bf16* U, bf16* HS, int g, int gt, int ngt) {
    const int n = T_ALL * 32;
    for (int i = gt; i < n; i += ngt) {
        const int t = i >> 5, chunk = g * 32 + (i & 31);
        const bool ctx = t < T_CTX;
        const int c = ctx ? (t & 255) : ((t - T_CTX) & 63), lim = ctx ? 256 : 64;
        u32x4 q[W];
#pragma unroll
        for (int j = 0; j < W; ++j) { const int cc = c - W / 2 + j; const bool ok = (unsigned)cc < (unsigned)lim;
            q[j] = ok ? *(const u32x4*)(U + (size_t)(t - c + cc) * DM + chunk * 8) : (u32x4){0u, 0u, 0u, 0u}; }
        float s[8] = {0.f, 0.f, 0.f, 0.f, 0.f, 0.f, 0.f, 0.f};
#pragma unroll
        for (int j = 0; j < W; ++j) { float f[8]; unpack8(q[j], f);
#pragma unroll
            for (int k = 0; k < 8; ++k) s[k] += f[k]; }
        *(u32x4*)(HS + (size_t)t * DM + chunk * 8) = pack8(s);
    }
}
__device__ __forceinline__ void hpool_phase(const Args& a, int gt, int ngt) {
    unsigned char* wsb = a.ws; asm volatile("" : "+s"(wsb));
    const bf16* U = (const bf16*)(wsb + WS_RA + RA_U); bf16* HS = (bf16*)(wsb + WS_H);
    hpool_g<2>(U, HS, 0, gt, ngt); hpool_g<4>(U, HS, 1, gt, ngt); hpool_g<8>(U, HS, 2, gt, ngt); hpool_g<16>(U, HS, 3, gt, ngt);
}
template <int W>
__device__ __forceinline__ void vpool_g(bf16* U, const bf16* HS, int g, int gt, int ngt) {
    const int n = T_ALL * 32;
    for (int i = gt; i < n; i += ngt) {
        const int t = i >> 5, chunk = g * 32 + (i & 31);
        float s[8] = {0.f, 0.f, 0.f, 0.f, 0.f, 0.f, 0.f, 0.f}; float cnt;
        if (t < T_CTX) {
            const int p = t & 255;
            unpack8(*(const u32x4*)(HS + (size_t)t * DM + chunk * 8), s);
            cnt = (float)(min(p - W / 2 + W, 256) - max(p - W / 2, 0));
        } else {
            const int pos = (t - T_CTX) & 4095, c = pos & 63, r = pos >> 6;
            u32x4 q[W];
#pragma unroll
            for (int j = 0; j < W; ++j) { const int rr = r - W / 2 + j; const bool ok = (unsigned)rr < 64u;
                q[j] = ok ? *(const u32x4*)(HS + (size_t)(t + (rr - r) * 64) * DM + chunk * 8) : (u32x4){0u, 0u, 0u, 0u}; }
#pragma unroll
            for (int j = 0; j < W; ++j) { float f[8]; unpack8(q[j], f);
#pragma unroll
                for (int k = 0; k < 8; ++k) s[k] += f[k]; }
            cnt = (float)((min(r - W / 2 + W, 64) - max(r - W / 2, 0)) * (min(c - W / 2 + W, 64) - max(c - W / 2, 0)));
        }
        float u[8]; unpack8(*(const u32x4*)(U + (size_t)t * DM + chunk * 8), u);
        const float inv = 1.0f / cnt;
#pragma unroll
        for (int k = 0; k < 8; ++k) s[k] = s[k] * inv - u[k];
        *(u32x4*)(U + (size_t)t * DM + chunk * 8) = pack8(s);
    }
}
__device__ __forceinline__ void vpool_phase(const Args& a, int gt, int ngt) {
    unsigned char* wsb = a.ws; asm volatile("" : "+s"(wsb));
    bf16* U = (bf16*)(wsb + WS_RA + RA_U); const bf16* HS = (const bf16*)(wsb + WS_H);
    vpool_g<2>(U, HS, 0, gt, ngt); vpool_g<4>(U, HS, 1, gt, ngt); vpool_g<8>(U, HS, 2, gt, ngt); vpool_g<16>(U, HS, 3, gt, ngt);
}
__device__ __forceinline__ void gatednorm_phase(const Args& a, int l, int gw, int ngw, int lane) {
    const bf16* Z = (const bf16*)(a.ws + WS_RA + RA_Z); bf16* Y = (bf16*)(a.ws + WS_RB);
    const float* g = a.in[21] + (size_t)l * DIN;
    constexpr int R = 2;
    for (int t0 = gw * R; t0 < T_ALL; t0 += ngw * R) {
        u32x4 yq[R][4], zq[R][4];
#pragma unroll
        for (int r = 0; r < R; ++r) { const bf16* yr = Y + (size_t)(t0 + r) * DIN; const bf16* zr = Z + (size_t)(t0 + r) * DIN;
#pragma unroll
            for (int j = 0; j < 4; ++j) { yq[r][j] = *(const u32x4*)(yr + (j * 64 + lane) * 8); zq[r][j] = *(const u32x4*)(zr + (j * 64 + lane) * 8); } }
        float s[R];
#pragma unroll
        for (int r = 0; r < R; ++r) { s[r] = 0.f;
#pragma unroll
            for (int j = 0; j < 4; ++j) { float y[8], z[8]; unpack8(yq[r][j], y); unpack8(zq[r][j], z);
#pragma unroll
                for (int k = 0; k < 8; ++k) { y[k] = y[k] * silu_f(z[k]); s[r] += y[k] * y[k]; }
                yq[r][j] = (u32x4){__float_as_uint(y[0]), __float_as_uint(y[1]), __float_as_uint(y[2]), __float_as_uint(y[3])};
                zq[r][j] = (u32x4){__float_as_uint(y[4]), __float_as_uint(y[5]), __float_as_uint(y[6]), __float_as_uint(y[7])}; } }
#pragma unroll
        for (int o = 1; o < 64; o <<= 1) {
#pragma unroll
            for (int r = 0; r < R; ++r) s[r] += __shfl_xor(s[r], o); }
#pragma unroll
        for (int r = 0; r < R; ++r) { const float rstd = __builtin_amdgcn_rsqf(s[r] * (1.f / DIN) + EPS); bf16* yr = Y + (size_t)(t0 + r) * DIN;
#pragma unroll
            for (int j = 0; j < 4; ++j) { const f32x4 g0 = *(const f32x4*)(g + (j * 64 + lane) * 8), g1 = *(const f32x4*)(g + (j * 64 + lane) * 8 + 4);
                float o[8] = {__uint_as_float(yq[r][j].x) * rstd * g0.x, __uint_as_float(yq[r][j].y) * rstd * g0.y, __uint_as_float(yq[r][j].z) * rstd * g0.z, __uint_as_float(yq[r][j].w) * rstd * g0.w,
                              __uint_as_float(zq[r][j].x) * rstd * g1.x, __uint_as_float(zq[r][j].y) * rstd * g1.y, __uint_as_float(zq[r][j].z) * rstd * g1.z, __uint_as_float(zq[r][j].w) * rstd * g1.w};
                *(u32x4*)(yr + (j * 64 + lane) * 8) = pack8(o); } }
    }
}
constexpr int RS_BC = 272, RS_X = 160;
constexpr int L_BI = 0, L_CI = 34816, L_XI = 69632, L_HI = 90112, L_CS = 110592, L_DTV = L_CS + 512, L_WV = L_CS + 1024, L_TOT = L_CS + 1536;
__device__ __forceinline__ s16x4 trd(LAS unsigned char* p) { return __builtin_amdgcn_ds_read_tr16_b64_v4i16((LAS s16x4*)p); }
__device__ __forceinline__ bf16x8 cat4(s16x4 a, s16x4 b) { return (bf16x8){a[0], a[1], a[2], a[3], b[0], b[1], b[2], b[3]}; }
#define MFMA16(A, B, C) __builtin_amdgcn_mfma_f32_16x16x32_bf16((A), (B), (C), 0, 0, 0)

template <bool BWD>
__device__ __forceinline__ void ssd_sweep(LAS unsigned char* lds, const bf16* XH, const bf16* BG, const bf16* CG, const float* DT, bf16* YH, int tok0, int nc, int h, float aneg, float dskip,
                                          const float* h0, float* hout, int tid, int wave, int lane) {
    const int lt = wave < 4 ? wave : 11 - wave;
    const int grp = h >> 3, dcol = (BWD ? 32 : 0) + h, scanw = BWD ? 4 : 0;
    const int cl = lane & 15, g = lane >> 4, q4 = (lane & 15) >> 2, pp = lane & 3;
    const int lcol = 16 * lt + cl;
    f32x4 hacc[4];
#pragma unroll
    for (int pt = 0; pt < 4; ++pt)
#pragma unroll
        for (int j = 0; j < 4; ++j) hacc[pt][j] = h0 ? h0[(size_t)(16 * pt + 4 * g + j) * 128 + lcol] : 0.f;
    u32x4 st[10]; float dts0 = 0.f, dts1 = 0.f; u32x2 yprev[4] = {(u32x2){0u, 0u}, (u32x2){0u, 0u}, (u32x2){0u, 0u}, (u32x2){0u, 0u}};
#define SSD_SB() __builtin_amdgcn_sched_barrier(0)
#define SSD_LOAD_CHUNK(c_) do { const int tokc_ = tok0 + (c_) * 128; \
        _Pragma("unroll") for (int r = 0; r < 2; ++r) { const int q = tid + 512 * r, row = q >> 3, c16 = q & 7; st[r] = *(const u32x4*)(XH + ((size_t)h * T_ALL + tokc_ + row) * 64 + c16 * 8); } \
        _Pragma("unroll") for (int r = 0; r < 4; ++r) { const int q = tid + 512 * r, row = q >> 4, c16 = q & 15; st[2 + r] = *(const u32x4*)(BG + ((size_t)grp * T_ALL + tokc_ + row) * 128 + c16 * 8); } \
        _Pragma("unroll") for (int r = 0; r < 4; ++r) { const int q = tid + 512 * r, row = q >> 4, c16 = q & 15; st[6 + r] = *(const u32x4*)(CG + ((size_t)grp * T_ALL + tokc_ + row) * 128 + c16 * 8); } \
        if (wave == scanw) { dts0 = DT[(size_t)(tokc_ + lane) * 64 + dcol]; dts1 = DT[(size_t)(tokc_ + 64 + lane) * 64 + dcol]; } \
        if (!BWD) { const bf16* yq = YH + (size_t)(tokc_ + lcol) * DIN + h * 64 + 4 * g; _Pragma("unroll") for (int pt = 0; pt < 4; ++pt) yprev[pt] = *(const u32x2*)(yq + 16 * pt); } \
    } while (0)
#define SSD_SCAN(cb_) do { if (wave == scanw) { \
        const float da0 = dts0 * aneg, da1 = dts1 * aneg; float p0 = da0, p1 = da1; \
        _Pragma("unroll") for (int o = 1; o < 64; o <<= 1) { const float t0 = __shfl_up(p0, o), t1 = __shfl_up(p1, o); if (lane >= o) { p0 += t0; p1 += t1; } } \
        const float tot0 = __shfl(p0, 63), tot1 = __shfl(p1, 63), total = tot0 + tot1; p1 += tot0; \
        const float c0 = BWD ? total - p0 + da0 : p0, c1 = BWD ? total - p1 + da1 : p1; \
        LAS float* CS = (LAS float*)(lds + (cb_)); \
        CS[lane] = c0; CS[64 + lane] = c1; CS[128 + lane] = dts0; CS[192 + lane] = dts1; \
        CS[256 + lane] = dts0 * fexp(total - c0); CS[320 + lane] = dts1 * fexp(total - c1); \
        if (lane == 0) CS[384] = total; } } while (0)
    if (BWD ? (wave < 4) : (wave >= 4)) __builtin_amdgcn_s_setprio(2);
    SSD_LOAD_CHUNK(BWD ? nc - 1 : 0);
    SSD_SCAN(L_CS);
    for (int step = 0; step < nc; ++step) {
        const int c = BWD ? nc - 1 - step : step;
        const int tokc = tok0 + c * 128;
        const int csb = L_CS + (step & 1) * 2048;
#pragma unroll
        for (int r = 0; r < 2; ++r) { const int q = tid + 512 * r, row = q >> 3, c16 = q & 7; *(LAS u32x4*)(lds + L_XI + row * RS_X + c16 * 16) = st[r]; }
#pragma unroll
        for (int r = 0; r < 4; ++r) { const int q = tid + 512 * r, row = q >> 4, c16 = q & 15; *(LAS u32x4*)(lds + L_BI + row * RS_BC + c16 * 16) = st[2 + r]; }
#pragma unroll
        for (int r = 0; r < 4; ++r) { const int q = tid + 512 * r, row = q >> 4, c16 = q & 15; *(LAS u32x4*)(lds + L_CI + row * RS_BC + c16 * 16) = st[6 + r]; }
#pragma unroll
        for (int pt = 0; pt < 4; ++pt) { u32x2 w; w.x = pk2(hacc[pt][0], hacc[pt][1]); w.y = pk2(hacc[pt][2], hacc[pt][3]);
            *(LAS u32x2*)(lds + L_HI + lcol * RS_X + (16 * pt + 4 * g) * 2) = w; }
        u32x2 ycur[4];
#pragma unroll
        for (int pt = 0; pt < 4; ++pt) ycur[pt] = yprev[pt];
        if (step + 1 < nc) SSD_LOAD_CHUNK(BWD ? c - 1 : c + 1);
        __syncthreads();
        {
            const float csl = *(LAS float*)(lds + csb + lcol * 4);
            bf16x8 cf[4];
#pragma unroll
            for (int k = 0; k < 4; ++k) cf[k] = *(LAS bf16x8*)(lds + L_CI + lcol * RS_BC + (32 * k + 8 * g) * 2);
            f32x4 yacc[4];
#pragma unroll
            for (int pt = 0; pt < 4; ++pt) yacc[pt] = (f32x4){0.f, 0.f, 0.f, 0.f};
            bf16x8 hf[2][4];
#define SSD_LD_H(buf_, k_) do { _Pragma("unroll") for (int pt = 0; pt < 4; ++pt) { LAS unsigned char* p0 = lds + L_HI + (32 * (k_) + 8 * g + q4) * RS_X + (16 * pt) * 2 + 8 * pp; \
                hf[buf_][pt] = cat4(trd(p0), trd(p0 + 4 * RS_X)); } } while (0)
            SSD_LD_H(0, 0);
            SSD_SB();
#pragma unroll
            for (int k = 0; k < 4; ++k) {
                if (k < 3) SSD_LD_H((k + 1) & 1, k + 1);
#pragma unroll
                for (int pt = 0; pt < 4; ++pt) yacc[pt] = MFMA16(hf[k & 1][pt], cf[k], yacc[pt]);
                SSD_SB();
            }
            const float el = fexp(csl);
#pragma unroll
            for (int pt = 0; pt < 4; ++pt) yacc[pt] *= el;
#pragma unroll 1
            for (int sb = 0; sb < 4; ++sb) {
                const bool need = BWD ? (2 * sb + 1 >= lt) : (2 * sb <= lt);
                if (!need) continue;
                bf16x8 ba[2][4]; f32x4 css[2], dtv[2]; bf16x8 xa[4];
#pragma unroll
                for (int u = 0; u < 2; ++u) {
#pragma unroll
                    for (int k = 0; k < 4; ++k) ba[u][k] = *(LAS bf16x8*)(lds + L_BI + (32 * sb + 16 * u + cl) * RS_BC + (32 * k + 8 * g) * 2);
                    css[u] = *(LAS f32x4*)(lds + csb + (32 * sb + 16 * u + 4 * g) * 4); dtv[u] = *(LAS f32x4*)(lds + csb + 512 + (32 * sb + 16 * u + 4 * g) * 4); }
#pragma unroll
                for (int pt = 0; pt < 4; ++pt) { LAS unsigned char* p0 = lds + L_XI + (32 * sb + 4 * g + q4) * RS_X + (16 * pt) * 2 + 8 * pp; xa[pt] = cat4(trd(p0), trd(p0 + 16 * RS_X)); }
                SSD_SB();
                f32x4 sacc[2] = {(f32x4){0.f, 0.f, 0.f, 0.f}, (f32x4){0.f, 0.f, 0.f, 0.f}};
#pragma unroll
                for (int k = 0; k < 4; ++k) { sacc[0] = MFMA16(ba[0][k], cf[k], sacc[0]); sacc[1] = MFMA16(ba[1][k], cf[k], sacc[1]); }
                f32x4 m[2];
#pragma unroll
                for (int u = 0; u < 2; ++u)
#pragma unroll
                    for (int j = 0; j < 4; ++j) { const int s = 32 * sb + 16 * u + 4 * g + j; const bool valid = BWD ? (s >= lcol) : (s <= lcol);
                        float v = valid ? sacc[u][j] * fexp(fminf(csl - css[u][j], 0.f)) * dtv[u][j] : 0.f;
                        if (!BWD && s == lcol) v += dskip;
                        m[u][j] = v; }
                u32x4 mw; mw.x = pk2(m[0][0], m[0][1]); mw.y = pk2(m[0][2], m[0][3]); mw.z = pk2(m[1][0], m[1][1]); mw.w = pk2(m[1][2], m[1][3]);
                const bf16x8 mf = __builtin_bit_cast(bf16x8, mw);
#pragma unroll
                for (int pt = 0; pt < 4; ++pt) yacc[pt] = MFMA16(xa[pt], mf, yacc[pt]);
                SSD_SB();
            }
            bf16* yp = YH + (size_t)(tokc + lcol) * DIN + h * 64 + 4 * g;
#pragma unroll
            for (int pt = 0; pt < 4; ++pt) { f32x4 v = yacc[pt];
                if (!BWD) { v[0] += blo(ycur[pt].x); v[1] += bhi(ycur[pt].x); v[2] += blo(ycur[pt].y); v[3] += bhi(ycur[pt].y); }
                u32x2 w; w.x = pk2(v[0], v[1]); w.y = pk2(v[2], v[3]); *(u32x2*)(yp + 16 * pt) = w; }
            const float dec = fexp(*(LAS float*)(lds + csb + 1536));
#pragma unroll
            for (int pt = 0; pt < 4; ++pt) hacc[pt] *= dec;
            s16x4 sb0[2], sb1[2]; f32x4 sw0[2], sw1[2]; bf16x8 sx[2][4];
#define SSD_LD_S(buf_, k_) do { LAS unsigned char* pb = lds + L_BI + (32 * (k_) + 8 * g + q4) * RS_BC + (16 * lt) * 2 + 8 * pp; \
                sb0[buf_] = trd(pb); sb1[buf_] = trd(pb + 4 * RS_BC); \
                sw0[buf_] = *(LAS f32x4*)(lds + csb + 1024 + (32 * (k_) + 8 * g) * 4); sw1[buf_] = *(LAS f32x4*)(lds + csb + 1024 + (32 * (k_) + 8 * g + 4) * 4); \
                _Pragma("unroll") for (int pt = 0; pt < 4; ++pt) { LAS unsigned char* p0 = lds + L_XI + (32 * (k_) + 8 * g + q4) * RS_X + (16 * pt) * 2 + 8 * pp; sx[buf_][pt] = cat4(trd(p0), trd(p0 + 4 * RS_X)); } } while (0)
            SSD_LD_S(0, 0);
            SSD_SB();
#pragma unroll
            for (int k = 0; k < 4; ++k) {
                if (k < 3) SSD_LD_S((k + 1) & 1, k + 1);
                const s16x4 b0 = sb0[k & 1], b1 = sb1[k & 1]; const f32x4 w0 = sw0[k & 1], w1 = sw1[k & 1];
                u32x4 bw;
                bw.x = pk2(__uint_as_float((unsigned)(unsigned short)b0[0] << 16) * w0[0], __uint_as_float((unsigned)(unsigned short)b0[1] << 16) * w0[1]);
                bw.y = pk2(__uint_as_float((unsigned)(unsigned short)b0[2] << 16) * w0[2], __uint_as_float((unsigned)(unsigned short)b0[3] << 16) * w0[3]);
                bw.z = pk2(__uint_as_float((unsigned)(unsigned short)b1[0] << 16) * w1[0], __uint_as_float((unsigned)(unsigned short)b1[1] << 16) * w1[1]);
                bw.w = pk2(__uint_as_float((unsigned)(unsigned short)b1[2] << 16) * w1[2], __uint_as_float((unsigned)(unsigned short)b1[3] << 16) * w1[3]);
                const bf16x8 bfr = __builtin_bit_cast(bf16x8, bw);
#pragma unroll
                for (int pt = 0; pt < 4; ++pt) hacc[pt] = MFMA16(sx[k & 1][pt], bfr, hacc[pt]);
                SSD_SB();
            }
            if (step + 1 < nc) SSD_SCAN(L_CS + ((step + 1) & 1) * 2048);
        }
        __syncthreads();
    }
    __builtin_amdgcn_s_setprio(0);
#undef SSD_LD_H
#undef SSD_LD_S
#undef SSD_SCAN
#undef SSD_LOAD_CHUNK
#undef SSD_SB
    if (hout) {
#pragma unroll
        for (int pt = 0; pt < 4; ++pt)
#pragma unroll
            for (int j = 0; j < 4; ++j) hout[(size_t)(16 * pt + 4 * g + j) * 128 + lcol] = hacc[pt][j];
    }
}
__device__ __forceinline__ void ssd_phase(const Args& a, int l, LAS unsigned char* lds, int vcu, int G, int tid, int wave, int lane) {
    unsigned char* wsb = a.ws; asm volatile("" : "+s"(wsb));
    { unsigned z_ = 0; asm volatile("" : "+s"(z_)); lds += z_; }
    const bf16* XH = (const bf16*)(wsb + WS_RA + RA_XH); const bf16* BG = (const bf16*)(wsb + WS_RA + RA_BG); const bf16* CG = (const bf16*)(wsb + WS_RA + RA_CG);
    const float* DT = (const float*)(wsb + WS_DT); bf16* YH = (bf16*)(wsb + WS_RB);
    for (int item = vcu; item < 256 + 512; item += G) {
        int tok0, nc, h; const float *h0f = nullptr, *h0b = nullptr; float *hof = nullptr, *hob = nullptr;
        if (item < 256) { const int b = item >> 5; h = item & 31; tok0 = T_CTX + b * 4096; nc = 32;
            h0f = a.in[2] + ((size_t)(b * 2 + l) * 32 + h) * 8192; h0b = a.in[3] + ((size_t)(b * 2 + l) * 32 + h) * 8192; }
        else { const int i2 = item - 256, b = i2 >> 5; h = i2 & 31; tok0 = b * 256; nc = 2;
            hof = a.out + OUT_SF + ((size_t)(b * 2 + l) * 32 + h) * 8192; hob = a.out + OUT_SB + ((size_t)(b * 2 + l) * 32 + h) * 8192; }
        const float af = -fexp(a.in[18][(size_t)l * 64 + h]), ab = -fexp(a.in[18][(size_t)l * 64 + 32 + h]);
        const float dsk = a.in[20][(size_t)l * 32 + h];
        ssd_sweep<true>(lds, XH, BG, CG, DT, YH, tok0, nc, h, ab, dsk, h0b, hob, tid, wave, lane);
        ssd_sweep<false>(lds, XH, BG, CG, DT, YH, tok0, nc, h, af, dsk, h0f, hof, tid, wave, lane);
    }
}

#define XB_TMO      128
#define XB_XCNT(j)  (256  + 64 * (j))
#define XB_XSUB(j)  (1280 + 64 * (j))
#define XB_XGEN(j)  (2304 + 64 * (j))
#define XB_TOP      3328
#define XB_TOPGEN   3392
#define XCD_BAR_WORDS 3456
#define XB_SPIN_CAP (1u << 18)

__device__ __forceinline__ unsigned xb_ld(unsigned* p)              { return __hip_atomic_load(p, __ATOMIC_RELAXED, __HIP_MEMORY_SCOPE_AGENT); }
__device__ __forceinline__ unsigned xb_add(unsigned* p, unsigned v) { return __hip_atomic_fetch_add(p, v, __ATOMIC_RELAXED, __HIP_MEMORY_SCOPE_AGENT); }
__device__ __forceinline__ unsigned xb_xcc_id() { return (unsigned)__builtin_amdgcn_s_getreg((3 << 11) | 20) & 0xFu; }
#define XB_SPIN(cond, bar) do { unsigned _sp = 0; while (cond) { __builtin_amdgcn_s_sleep(1); \
    if ((++_sp & 255u) == 0u) { if (xb_ld(&(bar)[XB_TMO])) break; if (_sp > XB_SPIN_CAP) { atomicAdd(&(bar)[XB_TMO], 1u); break; } } } } while (0)

struct XcdBarrier {
    unsigned* bar; unsigned x;
    volatile LAS unsigned* st;
};

__device__ __forceinline__ XcdBarrier xcd_barrier_post(unsigned* bar, volatile LAS unsigned* st) {
    XcdBarrier b; b.bar = bar; b.x = xb_xcc_id(); b.st = st;
    if (threadIdx.x == 0) (void)xb_add(&bar[XB_XCNT(b.x)], 1u);
    return b;
}
__device__ __forceinline__ void xcd_barrier_complete(unsigned* bar, unsigned x, unsigned& nloc, unsigned& nx) {
    const unsigned G = gridDim.x * gridDim.y * gridDim.z;
    unsigned sum, cnt, mine, sp = 0u;
    for (;;) {
        sum = 0u; cnt = 0u; mine = 0u;
#pragma unroll 1
        for (unsigned j = 0; j < 16; ++j) { const unsigned c = xb_ld(&bar[XB_XCNT(j)]); sum += c; cnt += (c > 0u) ? 1u : 0u; }
        mine = xb_ld(&bar[XB_XCNT(x)]);
        if (sum == G) break;
        __builtin_amdgcn_s_sleep(1);
        if ((++sp & 255u) == 0u) { if (xb_ld(&bar[XB_TMO])) break; if (sp > XB_SPIN_CAP) { atomicAdd(&bar[XB_TMO], 1u); break; } }
    }
    nloc = mine > 0u ? mine : 1u; nx = cnt > 0u ? cnt : 1u;
}

__device__ __forceinline__ void xcd_barrier(const XcdBarrier& b) {
    asm volatile("s_waitcnt vmcnt(0)" ::: "memory");
    __syncthreads();
    if (threadIdx.x == 0) {
        unsigned* bar = b.bar;
        __builtin_amdgcn_s_waitcnt(0);
        unsigned nloc = b.st[0], nx = b.st[1];
        if (nloc == 0u) { xcd_barrier_complete(bar, b.x, nloc, nx); b.st[0] = nloc; b.st[1] = nx; }
        const unsigned old = xb_add(&bar[XB_XSUB(b.x)], 1u);
        const unsigned gen = old / nloc;
        if (old + 1u == (gen + 1u) * nloc) {
            __builtin_amdgcn_fence(__ATOMIC_RELEASE, "agent");
            asm volatile("s_waitcnt vmcnt(0)" ::: "memory");
            const unsigned og = xb_add(&bar[XB_TOP], 1u);
            const unsigned tg = og / nx;
            if (og + 1u == (tg + 1u) * nx) xb_add(&bar[XB_TOPGEN], 1u);
            else XB_SPIN(xb_ld(&bar[XB_TOPGEN]) == tg, bar);
            __builtin_amdgcn_fence(__ATOMIC_ACQUIRE, "agent");
            xb_add(&bar[XB_XGEN(b.x)], 1u);
            asm volatile("s_waitcnt vmcnt(0)" ::: "memory");
        } else {
            XB_SPIN(xb_ld(&bar[XB_XGEN(b.x)]) == gen, bar);
            __builtin_amdgcn_fence(__ATOMIC_ACQUIRE, "agent");
            asm volatile("s_waitcnt vmcnt(0)" ::: "memory");
        }
    }
    __syncthreads();
}

__global__ void __launch_bounds__(NTHR, 2) hybrid_fwd(Args a) {
    extern __shared__ __attribute__((aligned(16))) unsigned char lds_raw[];
    LAS unsigned char* lds = (LAS unsigned char*)lds_raw;
    cg::grid_group grid = cg::this_grid();
    constexpr int G = 256; const int bid = blockIdx.x;
    const int vcu = (G % 8 == 0) ? (bid % 8) * (G / 8) + bid / 8 : bid;
    const int ngw = G * NWAVES, ngt = G * NTHR;
#define TIDS() int tid = threadIdx.x; asm volatile("" : "+v"(tid)); const int lane = tid & 63, wave = __builtin_amdgcn_readfirstlane(tid >> 6); const int gw = vcu * NWAVES + wave, gt = bid * NTHR + tid; (void)lane; (void)gw; (void)gt;
    unsigned char* ws = a.ws; unsigned char* wb = ws + WS_W;
    float* X = a.out; const float* MODB = (const float*)(ws + WS_MOD);
    const bf16* H = (const bf16*)(ws + WS_H);

    if (threadIdx.x < 64) ((LAS unsigned*)(lds + 131072))[threadIdx.x] = 0u;
    __syncthreads();
    XcdBarrier xbar = xcd_barrier_post((unsigned*)(ws + WS_BAR), (volatile LAS unsigned*)(lds + 131072));
#define GSYNC() xcd_barrier(xbar)
    constexpr bool split2 = true;
#define OPQ_S(v) asm volatile("" : "+s"(v))
#define PHV() int bid = blockIdx.x; OPQ_S(bid); unsigned char* ws = a.ws; OPQ_S(ws); unsigned char* wb = ws + WS_W; const bf16* H = (const bf16*)(ws + WS_H); float* X = a.out; (void)bid; (void)wb; (void)H; (void)X;
    { TIDS(); adaln_phase(a, lds, tid);
    __syncthreads();
    convert_phase(a, 0, lds, gw, ngw, wave, lane); }
    grid.sync();
#pragma unroll 1
    for (int l = 0; l < 2; ++l) {
        const float* mod = MODB + (size_t)l * 9 * 9216;
        if (l == 1) { TIDS(); convert_phase(a, 1, lds, gw, ngw, wave, lane); }
#pragma unroll 1
        for (int f = 0; f < 2; ++f) {
            if (f == 1) {
                { TIDS(); normmod_phase(a, l, 1, false, split2, gw, ngw, lane);
                  float* rss = (float*)(a.ws + WS_ROWSS); for (int i = gt; i < T_ALL; i += ngt) rss[i] = 0.f; }
                GSYNC();
#pragma unroll 1
                for (int hs = 0; hs < 2; ++hs) {
                    const int npc = hs ? 2 : 1;
#pragma unroll 1
                    for (int pc = 0; pc < npc; ++pc) {
                        const int tb = hs ? (pc ? 0 : 16384) : 1280, tcnt = hs ? (pc ? 1280 : 20480) : 15104, ro = (hs && !pc) ? 1280 : 0;
                        PHV(); const int cc = (hs && pc) ? ((bid >= 128 && bid < 193) ? bid - 128 : (1 << 20)) : bid;
                        pg8::Gemm g{H + (size_t)tb * DM, (const bf16*)(wb + WO_WINA), tcnt, NA_ROWS, DM, DM, DM, 0}; pg8::StaticOrder S; S.init(tcnt, NA_ROWS, G, cc);
                        pg8::EpiStore E{(bf16*)(ws + WS_RB) + (size_t)ro * CONVD, CONVD, 12, (float*)(ws + WS_DT) + (size_t)tb * 64, a.in[19] + (size_t)l * 64, 0, 0};
                        pg8::gemm_phase<pg8::EpiStore, pg8::StaticOrder>(lds, g, S, E);
                    }
                    GSYNC();
#pragma unroll 1
                    for (int pc = 0; pc < npc; ++pc) {
                        const int tb = hs ? (pc ? 0 : 16384) : 1280, tcnt = hs ? (pc ? 1280 : 20480) : 15104, ro = (hs && !pc) ? 1280 : 0;
                        TIDS(); conv_phase(a, l, tb, tcnt, ro, gw, ngw, lane);
                    }
                    GSYNC();
                }
                { TIDS(); ssd_phase(a, l, lds, vcu, G, tid, wave, lane); }
                GSYNC();
                { PHV(); pg8::Gemm g{H, (const bf16*)(wb + WO_WINB), T_ALL, DIN, DM, DM, DM, 0}; pg8::StaticOrder S; S.init(T_ALL, DIN, G, bid);
                  pg8::EpiYZ E{(bf16*)(ws + WS_RB), DIN, (float*)(ws + WS_ROWSS)};
                  pg8::gemm_phase<pg8::EpiYZ, pg8::StaticOrder>(lds, g, S, E); }
                GSYNC();
                { PHV(); pg8::Gemm g{H, (const bf16*)(wb + WO_WINB) + (size_t)DIN * DM, T_ALL, 3 * DM, DM, DM, DM, 0}; pg8::StaticOrder S; S.init(T_ALL, 3 * DM, G, bid);
                  pg8::EpiStore E{(bf16*)(ws + WS_RA + RA_U), DM, -1, nullptr, nullptr, 4, (size_t)T_ALL * DM};
                  pg8::gemm_phase<pg8::EpiStore, pg8::StaticOrder>(lds, g, S, E); }
                GSYNC();
                { TIDS(); hpool_phase(a, gt, ngt); }
                GSYNC();
                { TIDS(); vpool_phase(a, gt, ngt); }
                GSYNC();
                { PHV(); pg8::Gemm g{(const bf16*)(ws + WS_RB), (const bf16*)(wb + WO_WBS), T_ALL, DM, DIN, DIN, DIN, 0}; pg8::StaticOrder S; S.init(T_ALL, DM, G, bid);
                  pg8::EpiGate<3> E{(bf16*)(ws + WS_RA + RA_GB), DM, nullptr, (const bf16*)(ws + WS_RA + RA_GB), DM, (const float*)(ws + WS_ROWSS)};
                  pg8::gemm_phase<pg8::EpiGate<3>, pg8::StaticOrder>(lds, g, S, E); }
                { PHV(); const int nl = G / 4; pg8::Gemm g{(const bf16*)(ws + WS_RA + RA_U), (const bf16*)(wb + WO_PW), T_ALL, DM, 256, DM, 256, 512}; pg8::StaticOrder S; S.init(T_ALL, DM, G - nl, bid >= nl ? bid - nl : (1 << 20));
                  pg8::EpiGate<0> E{(bf16*)(ws + WS_H), DM, a.in[15] + (size_t)l * DM, nullptr, 0, nullptr};
                  pg8::gemm_phase<pg8::EpiGate<0>, pg8::StaticOrder>(lds, g, S, E); }
                GSYNC();
                { PHV(); pg8::Gemm g{H, (const bf16*)(wb + WO_WBP), T_ALL, DM, DM, DM, DM, 0}; pg8::StaticOrder S; S.init(T_ALL, DM, G, bid);
                  pg8::EpiGate<2> E{(bf16*)(ws + WS_RA + RA_GB), DM, nullptr, (const bf16*)(ws + WS_RA + RA_GA), DM, nullptr};
                  pg8::gemm_phase<pg8::EpiGate<2>, pg8::StaticOrder>(lds, g, S, E); }
                GSYNC();
                { PHV(); pg8::Gemm g{(const bf16*)(ws + WS_RA + RA_GB), (const bf16*)(wb + WO_WO), T_ALL, DM, DM, DM, DM, 0}; pg8::StaticOrder S; S.init(T_ALL, DM, G, bid);
                  pg8::EpiResid E{(const bf16*)X, (bf16*)X, a.in[0], a.in[1], mod, 5 * DM, 1.0f, 0, 0};
                  pg8::gemm_phase<pg8::EpiResid, pg8::StaticOrder>(lds, g, S, E); }
                GSYNC();
            }
            const bool use_in = (l == 0 && f == 0);
            { TIDS(); normmod_phase(a, l, f ? 2 : 0, use_in, split2 && f == 0 && l == 1, gw, ngw, lane); }
            GSYNC();
            { PHV(); pg8::Gemm g{H, (const bf16*)(wb + (f ? WO_W13B : WO_W13A)), T_ALL, 2 * DFF, DM, DM, DM, 0}; pg8::StaticOrder S; S.init(T_ALL, 2 * DFF, G, bid);
              pg8::EpiSwiGLU E{(bf16*)(ws + WS_RA), DFF};
              pg8::gemm_phase<pg8::EpiSwiGLU, pg8::StaticOrder>(lds, g, S, E); }
            GSYNC();
            {
              { PHV(); pg8::Gemm g{(const bf16*)(ws + WS_RA), (const bf16*)(wb + (f ? WO_W2B : WO_W2A)), T_ALL, DM, DFF, DFF, DFF, 0}; pg8::PanelOrder S{0, bid};
                pg8::EpiResid E{(const bf16*)X, (l == 1 && f == 1) ? (bf16*)(ws + WS_RB) : (bf16*)X, a.in[0], a.in[1], mod, (f ? 8 : 2) * DM, 0.5f, 0, use_in ? 1 : 0};
                pg8::gemm_phase<pg8::EpiResid, pg8::PanelOrder>(lds, g, S, E); }
              { PHV(); pg8::Gemm g{(const bf16*)(ws + WS_RA), (const bf16*)(wb + (f ? WO_W2B : WO_W2A)), T_ALL, DM, DFF / 2, DFF, DFF, 0}; pg8::PanelOrder S{1, bid};
                pg8::EpiResid E{(const bf16*)X, (l == 1 && f == 1) ? (bf16*)(ws + WS_RB) : (bf16*)X, a.in[0], a.in[1], mod, (f ? 8 : 2) * DM, 0.5f, 0, use_in ? 1 : 0};
                pg8::gemm_phase<pg8::EpiResid, pg8::PanelOrder>(lds, g, S, E); }
              { PHV(); pg8::Gemm g{(const bf16*)(ws + WS_RA) + DFF / 2, (const bf16*)(wb + (f ? WO_W2B : WO_W2A)) + DFF / 2, T_ALL, DM, DFF / 2, DFF, DFF, 0}; pg8::PanelOrder S{1, bid - 64};
                pg8::EpiDelta E{(bf16*)(ws + WS_D2), mod, (f ? 8 : 2) * DM, 0.5f};
                pg8::gemm_phase<pg8::EpiDelta, pg8::PanelOrder>(lds, g, S, E); }
            }
            GSYNC();
        }
    }
    { TIDS(); final_norm_phase(a, split2, gw, ngw, lane); }
}

extern "C" void kernel_launch(void* const* d_in, const int* in_sizes, int n_in, void* d_out, int out_size, void* d_ws, size_t ws_size, hipStream_t stream) {
    static int grid = 0;
    if (grid == 0) {
        if (n_in != 26 || ws_size < WS_END) { fprintf(stderr, "kernel_launch: unexpected n_in %d / ws_size %zu\n", n_in, ws_size); grid = -1; return; }
        int dev = 0, cus = 0, per_cu = 0;
        hipGetDevice(&dev);
        hipDeviceGetAttribute(&cus, hipDeviceAttributeMultiprocessorCount, dev);
        if (hipFuncSetAttribute((const void*)hybrid_fwd, hipFuncAttributeMaxDynamicSharedMemorySize, LDS_BYTES) != hipSuccess) { fprintf(stderr, "kernel_launch: hipFuncSetAttribute failed\n"); }
        if (hipOccupancyMaxActiveBlocksPerMultiprocessor(&per_cu, (const void*)hybrid_fwd, NTHR, LDS_BYTES) != hipSuccess || per_cu < 1) { fprintf(stderr, "kernel_launch: occupancy query gave %d\n", per_cu); per_cu = 1; }
        (void)hipGetLastError();
        grid = cus;
        if (grid != 256) { fprintf(stderr, "kernel_launch: built for a 256-CU device (got %d); nothing launched\n", grid); grid = -1; return; }
    }
    if (grid < 0) return;
    Args a{};
    for (int i = 0; i < 26; ++i) a.in[i] = (const float*)d_in[i];
    a.out = (float*)d_out; a.ws = (unsigned char*)d_ws;
    if (hipMemsetAsync((char*)d_ws + WS_BAR, 0, BAR_ZERO_BYTES, stream) != hipSuccess) { fprintf(stderr, "kernel_launch: memset failed\n"); return; }
    void* args[] = {&a};
    hipError_t e = hipLaunchCooperativeKernel((const void*)hybrid_fwd, dim3(grid), dim3(NTHR), args, LDS_BYTES, stream);
    if (e != hipSuccess) fprintf(stderr, "cooperative launch failed: %s (grid %d)\n", hipGetErrorString(e), grid);
}
```

```cpp
#include <hip/hip_runtime.h>
#include <hip/hip_cooperative_groups.h>
#include <cstdio>
#include <cstdint>
namespace pg8 {
#define PG8_LAS __attribute__((address_space(3)))
typedef unsigned short bf16_t;
typedef short bf16x8 __attribute__((ext_vector_type(8)));
typedef float f32x4 __attribute__((ext_vector_type(4)));
typedef unsigned u32x4 __attribute__((ext_vector_type(4)));
constexpr int BM = 256, BK = 64, HALF = 128, HTB = HALF * BK * 2  , STAGE_BYTES = 8 * HTB, NXCD = 8, WGM = 8;

__host__ __device__ __forceinline__ int lds_byte(int r, int c) { const int st = (r >> 4) * 2 + (c >> 5), rr = r & 15, cc = c & 31, ob = rr * 64 + cc * 2; return st * 1024 + (ob ^ (((ob >> 9) & 1) << 5)); }
__host__ __device__ __forceinline__ void stage_rc(int b, int& R, int& C) { const int st = b / 1024, sb = b % 1024, swz = sb ^ (((sb >> 9) & 1) << 5); R = (st >> 1) * 16 + swz / 64; C = (st & 1) * 32 + (swz % 64) / 2; }
__host__ __device__ __forceinline__ int perm32(int rho) { const int n = rho >> 4, i = rho & 15; return 8 * (i >> 2) + 4 * n + (i & 3); }

__device__ __forceinline__ float fexp(float x) { return __builtin_amdgcn_exp2f(x * 1.4426950408889634f); }
struct Unit { int pm, pn; };
struct Gemm { const bf16_t* A; const bf16_t* Bt; int M, N, K, lda, ldb, a_pn_bytes; };

struct StaticOrder {
    int nM, nN, nwg, G, c;
    __host__ __device__ void init(int M, int N, int G_, int c_) { nM = M / BM; nN = N / BM; nwg = nM * nN; G = G_; c = c_; }
    __host__ __device__ bool next(int i, Unit& u) const {
        const int L = i * G + c; if (L >= nwg) return false;
        int wgid = L; { const int q = nwg / NXCD, r = nwg % NXCD, xcd = wgid % NXCD, off = wgid / NXCD; wgid = (xcd < r ? xcd * (q + 1) : r * (q + 1) + (xcd - r) * q) + off; }
        const int nig = WGM * nN, gid = wgid / nig, fm = gid * WGM, gsz = (nM - fm) < WGM ? (nM - fm) : WGM;
        u.pm = fm + ((wgid % nig) % gsz); u.pn = (wgid % nig) / gsz; return true;
    }
    __device__ __forceinline__ void a_ready(const Unit&) const {}
    __device__ __forceinline__ void done(const Unit&) const {}
};

struct PanelOrder {
    int mode, c;
    __device__ __forceinline__ bool next(int i, Unit& u) const {
        const int xcd = c & 7, slot = c >> 3;
        if (mode == 0) { if (i >= 2) return false; u.pm = i * 64 + xcd * 8 + (slot >> 2); u.pn = slot & 3; return true; }
        if (i >= 1 || c < 0 || c >= 64) return false;
        u.pm = 128 + xcd * 2 + (slot >> 2); u.pn = slot & 3; return true;
    }
    __device__ __forceinline__ void a_ready(const Unit&) const {}
    __device__ __forceinline__ void done(const Unit&) const {}
};

__device__ __forceinline__ unsigned cvt_pk_bf16(float lo, float hi) { unsigned r; asm volatile("v_cvt_pk_bf16_f32 %0, %1, %2" : "=v"(r) : "v"(lo), "v"(hi)); return r; }

#define PG8_GAS __attribute__((address_space(1)))
__device__ __forceinline__ float bf_lo(unsigned u) { return __uint_as_float(u << 16); }
__device__ __forceinline__ float bf_hi(unsigned u) { return __uint_as_float(u & 0xffff0000u); }
__device__ __forceinline__ float fsilu(float v) { return v * __builtin_amdgcn_rcpf(1.0f + fexp(-v)); }
__device__ __forceinline__ float fsigm(float v) { return __builtin_amdgcn_rcpf(1.0f + fexp(-v)); }
__device__ __forceinline__ float softplus_f(float x) { const float e = fexp(-fabsf(x)); const float l = e < 0.0078125f ? e * (1.0f + e * (-0.5f + e * 0.33333333f)) : (__builtin_amdgcn_logf(1.0f + e) * 0.69314718056f); return fmaxf(x, 0.f) + l; }

struct EpiSwiGLU {
    static constexpr bool PERM = true, AFTER_DRAIN = false;
    bf16_t* O; int ldc;
    __device__ __forceinline__ void operator()(const f32x4 (&acc)[2][2][4][2], const Unit& u, int wr, int wc, int fr, int fq) const {
        const int row0 = u.pm * BM + wr * 64 + fr, col0 = u.pn * HALF + wc * 32 + 8 * fq;
#pragma unroll
        for (int ai = 0; ai < 2; ++ai)
#pragma unroll
            for (int m = 0; m < 4; ++m) { bf16_t* rowp = O + (size_t)(row0 + ai * HALF + m * 16) * ldc + col0;
                float v[8];
#pragma unroll
                for (int n = 0; n < 2; ++n)
#pragma unroll
                    for (int i = 0; i < 4; ++i) v[n * 4 + i] = fsilu(acc[ai][0][m][n][i]) * acc[ai][1][m][n][i];
                u32x4 w; w.x = cvt_pk_bf16(v[0], v[1]); w.y = cvt_pk_bf16(v[2], v[3]); w.z = cvt_pk_bf16(v[4], v[5]); w.w = cvt_pk_bf16(v[6], v[7]);
                *(PG8_GAS u32x4*)rowp = w; }
    }
};
struct EpiResid {
    static constexpr bool PERM = true, AFTER_DRAIN = false;
    const bf16_t* XB; bf16_t* XO; const float* xp; const float* xs; const float* mod; int gate_off; float scale; int pm0; int use_in;
    __device__ __forceinline__ void operator()(const f32x4 (&acc)[2][2][4][2], const Unit& u, int wr, int wc, int fr, int fq) const {
        const int pmg = u.pm + pm0;
        const int mrow = pmg < 16 ? 0 : 1 + ((pmg - 16) >> 4);
        const float* gate = mod + (size_t)mrow * 9216 + gate_off;
        const int col0 = u.pn * BM + wc * 32 + 8 * fq;
        const unsigned e0 = (unsigned)((wr * 64 + fr) * 1024 + col0);
        char* db = (char*)(XO + (size_t)pmg * 256 * 1024);
        if (use_in) {
            const char* sb = (const char*)(pmg < 16 ? xp + (size_t)pmg * 256 * 1024 : xs + (size_t)(pmg - 16) * 256 * 1024);
#pragma unroll
            for (int bj = 0; bj < 2; ++bj) {
                const f32x4 g0 = *(const PG8_GAS f32x4*)(gate + col0 + bj * HALF) * scale, g1 = *(const PG8_GAS f32x4*)(gate + col0 + bj * HALF + 4) * scale;
#pragma unroll
                for (int ai = 0; ai < 2; ++ai)
#pragma unroll
                  for (int mh = 0; mh < 4; mh += 2) {
                    f32x4 r0[2], r1[2];
                    unsigned eb = e0 + (unsigned)((ai * HALF + mh * 16) * 1024 + bj * HALF); asm volatile("" : "+v"(eb));
#pragma unroll
                    for (int m = 0; m < 2; ++m) { const unsigned e = eb + (unsigned)(m * 16 * 1024); r0[m] = *(const PG8_GAS f32x4*)(sb + e * 4u); r1[m] = *(const PG8_GAS f32x4*)(sb + e * 4u + 16u); }
#pragma unroll
                    for (int m = 0; m < 2; ++m) { const unsigned e = eb + (unsigned)(m * 16 * 1024);
                        const f32x4 v0 = r0[m] + g0 * acc[ai][bj][mh + m][0], v1 = r1[m] + g1 * acc[ai][bj][mh + m][1];
                        u32x4 w; w.x = cvt_pk_bf16(v0[0], v0[1]); w.y = cvt_pk_bf16(v0[2], v0[3]); w.z = cvt_pk_bf16(v1[0], v1[1]); w.w = cvt_pk_bf16(v1[2], v1[3]);
                        *(PG8_GAS u32x4*)(db + e * 2u) = w; }
                    asm volatile("" ::: "memory");
                  }
            }
        } else {
            const char* sb = (const char*)(XB + (size_t)pmg * 256 * 1024);
#pragma unroll
            for (int bj = 0; bj < 2; ++bj) {
                const f32x4 g0 = *(const PG8_GAS f32x4*)(gate + col0 + bj * HALF) * scale, g1 = *(const PG8_GAS f32x4*)(gate + col0 + bj * HALF + 4) * scale;
                {
                    u32x4 r[2][4];
                    unsigned eb = e0 + (unsigned)(bj * HALF); asm volatile("" : "+v"(eb));
#pragma unroll
                    for (int ai = 0; ai < 2; ++ai)
#pragma unroll
                    for (int m = 0; m < 4; ++m) { const unsigned e = eb + (unsigned)((ai * HALF + m * 16) * 1024); r[ai][m] = *(const PG8_GAS u32x4*)(sb + e * 2u); }
#pragma unroll
                    for (int ai = 0; ai < 2; ++ai)
#pragma unroll
                    for (int m = 0; m < 4; ++m) { const unsigned e = eb + (unsigned)((ai * HALF + m * 16) * 1024);
                        const u32x4 q = r[ai][m]; const f32x4 a0 = acc[ai][bj][m][0], a1 = acc[ai][bj][m][1];
                        u32x4 w;
                        w.x = cvt_pk_bf16(bf_lo(q.x) + g0[0] * a0[0], bf_hi(q.x) + g0[1] * a0[1]); w.y = cvt_pk_bf16(bf_lo(q.y) + g0[2] * a0[2], bf_hi(q.y) + g0[3] * a0[3]);
                        w.z = cvt_pk_bf16(bf_lo(q.z) + g1[0] * a1[0], bf_hi(q.z) + g1[1] * a1[1]); w.w = cvt_pk_bf16(bf_lo(q.w) + g1[2] * a1[2], bf_hi(q.w) + g1[3] * a1[3]);
                        *(PG8_GAS u32x4*)(db + e * 2u) = w; }
                    asm volatile("" ::: "memory");
                }
            }
        }
    }
};
struct EpiDelta {
    static constexpr bool PERM = true, AFTER_DRAIN = false;
    bf16_t* D2; const float* mod; int gate_off; float scale;
    __device__ __forceinline__ void operator()(const f32x4 (&acc)[2][2][4][2], const Unit& u, int wr, int wc, int fr, int fq) const {
        const int mrow = u.pm < 16 ? 0 : 1 + ((u.pm - 16) >> 4);
        const float* gate = mod + (size_t)mrow * 9216 + gate_off;
        const int row0 = (u.pm - 128) * BM + wr * 64 + fr, col0 = u.pn * BM + wc * 32 + 8 * fq;
#pragma unroll
        for (int bj = 0; bj < 2; ++bj) {
            const f32x4 g0 = *(const PG8_GAS f32x4*)(gate + col0 + bj * HALF) * scale, g1 = *(const PG8_GAS f32x4*)(gate + col0 + bj * HALF + 4) * scale;
#pragma unroll
            for (int ai = 0; ai < 2; ++ai)
#pragma unroll
                for (int m = 0; m < 4; ++m) { const f32x4 v0 = acc[ai][bj][m][0] * g0, v1 = acc[ai][bj][m][1] * g1;
                    u32x4 w; w.x = cvt_pk_bf16(v0[0], v0[1]); w.y = cvt_pk_bf16(v0[2], v0[3]); w.z = cvt_pk_bf16(v1[0], v1[1]); w.w = cvt_pk_bf16(v1[2], v1[3]);
                    *(PG8_GAS u32x4*)(D2 + (size_t)(row0 + ai * HALF + m * 16) * 1024 + col0 + bj * HALF) = w; }
        }
    }
};
struct EpiYZ {
    static constexpr bool PERM = true, AFTER_DRAIN = false;
    bf16_t* Y; int ldc; float* rowss;
    __device__ __forceinline__ void operator()(const f32x4 (&acc)[2][2][4][2], const Unit& u, int wr, int wc, int fr, int fq) const {
        const int row0 = u.pm * BM + wr * 64 + fr, col0 = u.pn * BM + wc * 32 + 8 * fq;
#pragma unroll
        for (int ai = 0; ai < 2; ++ai) {
            float ss[4] = {0.f, 0.f, 0.f, 0.f};
            unsigned eb = (unsigned)((row0 + ai * HALF) * ldc + col0); asm volatile("" : "+v"(eb));
            u32x4 yq[2][4];
#pragma unroll
            for (int bj = 0; bj < 2; ++bj)
#pragma unroll
                for (int m = 0; m < 4; ++m) yq[bj][m] = *(const PG8_GAS u32x4*)((const char*)Y + ((size_t)eb + (size_t)(m * 16 * ldc + bj * HALF)) * 2u);
#pragma unroll
            for (int bj = 0; bj < 2; ++bj) {
#pragma unroll
                for (int m = 0; m < 4; ++m) { const f32x4 a0 = acc[ai][bj][m][0], a1 = acc[ai][bj][m][1]; const u32x4 q = yq[bj][m];
                    const float v0 = bf_lo(q.x) * fsilu(a0[0]), v1 = bf_hi(q.x) * fsilu(a0[1]), v2 = bf_lo(q.y) * fsilu(a0[2]), v3 = bf_hi(q.y) * fsilu(a0[3]);
                    const float v4 = bf_lo(q.z) * fsilu(a1[0]), v5 = bf_hi(q.z) * fsilu(a1[1]), v6 = bf_lo(q.w) * fsilu(a1[2]), v7 = bf_hi(q.w) * fsilu(a1[3]);
                    ss[m] += (v0 * v0 + v1 * v1) + (v2 * v2 + v3 * v3) + (v4 * v4 + v5 * v5) + (v6 * v6 + v7 * v7);
                    u32x4 w; w.x = cvt_pk_bf16(v0, v1); w.y = cvt_pk_bf16(v2, v3); w.z = cvt_pk_bf16(v4, v5); w.w = cvt_pk_bf16(v6, v7);
                    *(PG8_GAS u32x4*)((char*)Y + ((size_t)eb + (size_t)(m * 16 * ldc + bj * HALF)) * 2u) = w; }
                asm volatile("" ::: "memory");
            }
#pragma unroll
            for (int m = 0; m < 4; ++m) { float s = ss[m]; s += __shfl_xor(s, 16); s += __shfl_xor(s, 32);
                if (fq == 0) (void)__builtin_amdgcn_global_atomic_fadd_f32((__attribute__((address_space(1))) float*)(rowss + row0 + ai * HALF + m * 16), s); }
        }
    }
};
struct EpiStore {
    static constexpr bool PERM = true, AFTER_DRAIN = false;
    bf16_t* O; int ldc; int dt_pn; float* DT; const float* dtb; int split_pn; size_t split_stride;
    __device__ __forceinline__ void operator()(const f32x4 (&acc)[2][2][4][2], const Unit& u, int wr, int wc, int fr, int fq) const {
        const int row0 = u.pm * BM + wr * 64 + fr;
        if (u.pn == dt_pn) {
            if (wc < 2) {
                const int c0 = wc * 32 + 8 * fq;
                f32x4 b0 = *(const PG8_GAS f32x4*)(dtb + c0), b1 = *(const PG8_GAS f32x4*)(dtb + c0 + 4);
#pragma unroll
                for (int ai = 0; ai < 2; ++ai)
#pragma unroll
                    for (int m = 0; m < 4; ++m) { float* rowp = DT + (size_t)(row0 + ai * HALF + m * 16) * 64 + c0;
                        f32x4 v0 = acc[ai][0][m][0] + b0, v1 = acc[ai][0][m][1] + b1;
#pragma unroll
                        for (int i = 0; i < 4; ++i) { v0[i] = softplus_f(v0[i]); v1[i] = softplus_f(v1[i]); }
                        *(PG8_GAS f32x4*)rowp = v0; *(PG8_GAS f32x4*)(rowp + 4) = v1; }
            }
            return;
        }
        int pnl = u.pn; bf16_t* base = O;
        if (split_pn > 0) { const int t = u.pn / split_pn; pnl = u.pn - t * split_pn; base = O + (size_t)t * split_stride; }
        const int col0 = pnl * BM + wc * 32 + 8 * fq;
#pragma unroll
        for (int ai = 0; ai < 2; ++ai)
#pragma unroll
            for (int m = 0; m < 4; ++m) { bf16_t* rowp = base + (size_t)(row0 + ai * HALF + m * 16) * ldc + col0;
#pragma unroll
                for (int bj = 0; bj < 2; ++bj) { const f32x4 v0 = acc[ai][bj][m][0], v1 = acc[ai][bj][m][1];
                    u32x4 w; w.x = cvt_pk_bf16(v0[0], v0[1]); w.y = cvt_pk_bf16(v0[2], v0[3]); w.z = cvt_pk_bf16(v1[0], v1[1]); w.w = cvt_pk_bf16(v1[2], v1[3]);
                    *(PG8_GAS u32x4*)(rowp + bj * HALF) = w; } }
    }
};
template <int MODE> struct EpiGate {
    static constexpr bool PERM = true, AFTER_DRAIN = false;
    static constexpr int MB = 4;
    bf16_t* O; int ldc; const float* cs; const bf16_t* G; int ldg; const float* rowss;
    __device__ __forceinline__ void operator()(const f32x4 (&acc)[2][2][4][2], const Unit& u, int wr, int wc, int fr, int fq) const {
        const int row0 = u.pm * BM + wr * 64 + fr, col0 = u.pn * BM + wc * 32 + 8 * fq;
#pragma unroll
        for (int bj = 0; bj < 2; ++bj) {
            f32x4 s0 = (f32x4){1.f, 1.f, 1.f, 1.f}, s1 = s0;
            if (MODE == 0) { s0 = *(const PG8_GAS f32x4*)(cs + col0 + bj * HALF); s1 = *(const PG8_GAS f32x4*)(cs + col0 + bj * HALF + 4); }
#pragma unroll
            for (int ai = 0; ai < 2; ++ai)
#pragma unroll
              for (int mh = 0; mh < 4; mh += MB) {
                u32x4 gq[4], oq[4]; float rsv[4] = {1.f, 1.f, 1.f, 1.f};
                if (MODE != 0) {
#pragma unroll
                    for (int m = mh; m < mh + MB; ++m) { const int row = row0 + ai * HALF + m * 16;
                        if (MODE == 3) rsv[m] = ((const PG8_GAS float*)rowss)[row];
                        gq[m] = *(const PG8_GAS u32x4*)(G + (size_t)row * ldg + col0 + bj * HALF);
                        if (MODE == 2) oq[m] = *(const PG8_GAS u32x4*)(O + (size_t)row * ldc + col0 + bj * HALF); }
                }
#pragma unroll
                for (int m = mh; m < mh + MB; ++m) { const int row = row0 + ai * HALF + m * 16; bf16_t* rowp = O + (size_t)row * ldc + col0 + bj * HALF;
                    const f32x4 a0 = acc[ai][bj][m][0], a1 = acc[ai][bj][m][1];
                    float v[8] = {a0[0], a0[1], a0[2], a0[3], a1[0], a1[1], a1[2], a1[3]};
                    if (MODE == 0) {
#pragma unroll
                        for (int i = 0; i < 4; ++i) { v[i] *= s0[i]; v[4 + i] *= s1[i]; } }
                    else { const unsigned gw[4] = {gq[m].x, gq[m].y, gq[m].z, gq[m].w};
                        const float rr = (MODE == 3) ? __builtin_amdgcn_rsqf((rsv[m] + 2048.0f * 1e-6f) * (1.0f / 2048.0f)) : 1.0f;
#pragma unroll
                        for (int i = 0; i < 4; ++i) { v[2 * i] *= fsigm(bf_lo(gw[i])) * rr; v[2 * i + 1] *= fsigm(bf_hi(gw[i])) * rr; }
                        if (MODE == 2) { const unsigned ow[4] = {oq[m].x, oq[m].y, oq[m].z, oq[m].w};
#pragma unroll
                            for (int i = 0; i < 4; ++i) { v[2 * i] += bf_lo(ow[i]); v[2 * i + 1] += bf_hi(ow[i]); } } }
                    u32x4 w; w.x = cvt_pk_bf16(v[0], v[1]); w.y = cvt_pk_bf16(v[2], v[3]); w.z = cvt_pk_bf16(v[4], v[5]); w.w = cvt_pk_bf16(v[6], v[7]);
                    *(PG8_GAS u32x4*)rowp = w; }
                asm volatile("" ::: "memory");
            }
        }
    }
};

template <class Epi, class Sched>
__device__ __forceinline__ void gemm_phase(PG8_LAS unsigned char* lds_in, const Gemm g, const Sched& S, const Epi& E) {
    PG8_LAS unsigned char* lds = lds_in; { unsigned z_ = 0; asm volatile("" : "+s"(z_)); lds += z_; }
    int tid_ = threadIdx.x; asm volatile("" : "+v"(tid_));
    const int tid = tid_, wid = __builtin_amdgcn_readfirstlane(tid >> 6), lane = tid & 63, wr = wid >> 2, wc = wid & 3, fr = lane & 15, fq = lane >> 4;
    const int K = g.K, nt = K / BK, lda = g.lda, ldb = g.ldb;
    unsigned voffA[2], voffB[2];
#pragma unroll
    for (int i = 0; i < 2; ++i) { int R, C; stage_rc(tid * 16 + i * 8192, R, C); const int Rb = Epi::PERM ? ((R & ~31) + perm32(R & 31)) : R;
        voffA[i] = (unsigned)(R * lda + C) * 2u; voffB[i] = (unsigned)(Rb * ldb + C) * 2u; }
    const size_t kstep = (size_t)(BK * 2);
    const size_t hstepA = (size_t)HALF * lda * 2, hstepB = (size_t)HALF * ldb * 2, acol = (size_t)g.a_pn_bytes;
    const size_t tstepA = 2 * hstepA, tstepB = 2 * hstepB;
    const unsigned ldsw = (unsigned)wid * 1024u;
    const int aoff = lds_byte(wr * 64 + fr, fq * 8), boff = lds_byte(wc * 32 + fr, fq * 8);
#define PG8_SA(b, h) (((b) * 2 + (h)) * HTB)
#define PG8_SB(b, h) ((4 + (b) * 2 + (h)) * HTB)
#define PG8_STAGE(bufoff, gbase, voff) do { _Pragma("unroll") for (int _i = 0; _i < 2; ++_i) \
        __builtin_amdgcn_global_load_lds((const unsigned*)((const char*)(gbase) + (voff)[_i]), (PG8_LAS unsigned*)(lds + (bufoff) + ldsw + _i * 8192), 16, 0, 0); } while (0)
#define PG8_LDA(dst, b, h) do { _Pragma("unroll") for (int m = 0; m < 4; ++m) _Pragma("unroll") for (int k = 0; k < 2; ++k) dst[m][k] = *(const PG8_LAS bf16x8*)(lds + PG8_SA(b, h) + aoff + m * 2048 + k * 1024); } while (0)
#define PG8_LDB(dst, b, h) do { _Pragma("unroll") for (int n = 0; n < 2; ++n) _Pragma("unroll") for (int k = 0; k < 2; ++k) dst[n][k] = *(const PG8_LAS bf16x8*)(lds + PG8_SB(b, h) + boff + n * 2048 + k * 1024); } while (0)
#define PG8_MMA(ai, bj, At, Bt) do { __builtin_amdgcn_s_setprio(1); _Pragma("unroll") for (int m = 0; m < 4; ++m) _Pragma("unroll") for (int n = 0; n < 2; ++n) _Pragma("unroll") for (int k = 0; k < 2; ++k) \
        acc[ai][bj][m][n] = __builtin_amdgcn_mfma_f32_16x16x32_bf16(Bt[n][k], At[m][k], acc[ai][bj][m][n], 0, 0, 0); __builtin_amdgcn_s_setprio(0); } while (0)
#define PG8_WAIT_V(n) asm volatile("s_waitcnt vmcnt(" #n ")" ::: "memory")
#define PG8_WAIT_L(n) asm volatile("s_waitcnt lgkmcnt(" #n ")" ::: "memory")
#define PG8_BAR __builtin_amdgcn_s_barrier()
#define PG8_SCHED __builtin_amdgcn_sched_barrier(0)
    Unit cur, nxt; int ui = 0;
    if (!S.next(0, cur)) return;
    f32x4 acc[2][2][4][2];
#pragma unroll
    for (int a = 0; a < 2; ++a)
#pragma unroll
        for (int b = 0; b < 2; ++b)
#pragma unroll
            for (int m = 0; m < 4; ++m)
#pragma unroll
                for (int n = 0; n < 2; ++n) acc[a][b][m][n] = (f32x4){0.f, 0.f, 0.f, 0.f};
    bf16x8 At[4][2], B0[2][2], B1[2][2];
    const char* cA = (const char*)g.A + (size_t)cur.pm * tstepA + (size_t)cur.pn * acol; const char* cB = (const char*)g.Bt + (size_t)cur.pn * tstepB;
    S.a_ready(cur);
    PG8_STAGE(PG8_SB(0, 0), cB, voffB); PG8_STAGE(PG8_SA(0, 0), cA, voffA); PG8_STAGE(PG8_SB(0, 1), cB + hstepB, voffB); PG8_STAGE(PG8_SA(0, 1), cA + hstepA, voffA);
    if (wr == 1) PG8_BAR;
    PG8_WAIT_V(4); PG8_BAR;
    PG8_STAGE(PG8_SB(1, 0), cB + kstep, voffB); PG8_STAGE(PG8_SA(1, 0), cA + kstep, voffA); PG8_STAGE(PG8_SB(1, 1), cB + hstepB + kstep, voffB);
    PG8_WAIT_V(6); PG8_BAR;
    for (;;) {
        const bool has_next = S.next(ui + 1, nxt);
        const char* nA = has_next ? (const char*)g.A + (size_t)nxt.pm * tstepA + (size_t)nxt.pn * acol : cA; const char* nB = has_next ? (const char*)g.Bt + (size_t)nxt.pn * tstepB : cB;
        for (int t = 0; t < nt; t += 2) {
            const bool last = (t == nt - 2);
            const char* a1 = cA + (size_t)(t + 1) * kstep;
            const char* a2 = last ? nA : cA + (size_t)(t + 2) * kstep; const char* b2 = last ? nB : cB + (size_t)(t + 2) * kstep;
            const char* a3 = a2 + kstep; const char* b3 = b2 + kstep;
            if (last && has_next) S.a_ready(nxt);
            PG8_LDB(B0, 0, 0); PG8_SCHED; PG8_LDA(At, 0, 0); PG8_STAGE(PG8_SA(1, 1), a1 + hstepA, voffA);
            PG8_WAIT_L(8); PG8_BAR; PG8_WAIT_L(0); PG8_MMA(0, 0, At, B0); PG8_BAR; PG8_SCHED;
            PG8_LDB(B1, 0, 1); PG8_STAGE(PG8_SB(0, 0), b2, voffB);
            PG8_BAR; PG8_WAIT_L(0); PG8_MMA(0, 1, At, B1); PG8_BAR;
            PG8_LDA(At, 0, 1); PG8_STAGE(PG8_SA(0, 0), a2, voffA);
            PG8_BAR; PG8_WAIT_L(0); PG8_MMA(1, 0, At, B0); PG8_BAR; PG8_SCHED;
            PG8_STAGE(PG8_SB(0, 1), b2 + hstepB, voffB);
            PG8_WAIT_V(6); PG8_BAR; PG8_MMA(1, 1, At, B1); PG8_BAR;
            PG8_LDB(B0, 1, 0); PG8_SCHED; PG8_LDA(At, 1, 0); PG8_STAGE(PG8_SA(0, 1), a2 + hstepA, voffA);
            PG8_WAIT_L(8); PG8_BAR; PG8_WAIT_L(0); PG8_MMA(0, 0, At, B0); PG8_BAR; PG8_SCHED;
            PG8_LDB(B1, 1, 1); PG8_STAGE(PG8_SB(1, 0), b3, voffB);
            PG8_BAR; PG8_WAIT_L(0); PG8_MMA(0, 1, At, B1); PG8_BAR;
            PG8_LDA(At, 1, 1); PG8_STAGE(PG8_SA(1, 0), a3, voffA);
            PG8_BAR; PG8_WAIT_L(0); PG8_MMA(1, 0, At, B0); PG8_BAR; PG8_SCHED;
            PG8_STAGE(PG8_SB(1, 1), b3 + hstepB, voffB);
            PG8_WAIT_V(6); PG8_BAR; PG8_MMA(1, 1, At, B1); PG8_BAR;
        }
        if constexpr (!Epi::AFTER_DRAIN) { E(acc, cur, wr, wc, fr, fq); S.done(cur); }
        if (!has_next) break;
#pragma unroll
        for (int a = 0; a < 2; ++a)
#pragma unroll
            for (int b = 0; b < 2; ++b)
#pragma unroll
                for (int m = 0; m < 4; ++m)
#pragma unroll
                    for (int n = 0; n < 2; ++n) acc[a][b][m][n] = (f32x4){0.f, 0.f, 0.f, 0.f};
        cur = nxt; cA = nA; cB = nB; ++ui;
    }
    PG8_WAIT_V(0);
    if (wr == 0) PG8_BAR;
    PG8_BAR;
    if constexpr (Epi::AFTER_DRAIN) { E.fused(acc, cur, wr, wc, fr, fq, lds, wid, lane); S.done(cur); }
#undef PG8_SA
#undef PG8_SB
#undef PG8_STAGE
#undef PG8_LDA
#undef PG8_LDB
#undef PG8_MMA
#undef PG8_WAIT_V
#undef PG8_WAIT_L
#undef PG8_BAR
#undef PG8_SCHED
}
}

namespace cg = cooperative_groups;
using pg8::fexp;
#define LAS __attribute__((address_space(3)))
typedef unsigned short bf16;
typedef short bf16x8 __attribute__((ext_vector_type(8)));
typedef short s16x4 __attribute__((ext_vector_type(4)));
typedef float f32x4 __attribute__((ext_vector_type(4)));
typedef unsigned u32x4 __attribute__((ext_vector_type(4)));
typedef unsigned u32x2 __attribute__((ext_vector_type(2)));

constexpr int DM = 1024, T_CTX = 4096, T_LAT = 32768, T_ALL = T_CTX + T_LAT, DFF = 2816, DIN = 2048, CONVD = 3072, NHEAD = 32;
constexpr int NWAVES = 8, NTHR = 512;
constexpr int LDS_BYTES = 131072 + 256;
constexpr size_t WS_BAR = 768 * 1024, BAR_ZERO_BYTES = 16384;
constexpr size_t WS_ROWSS = 800 * 1024;
constexpr float EPS = 1e-6f;
constexpr size_t MiB = 1u << 20;
constexpr size_t WS_MOD = 0;
constexpr size_t WS_W = 1 * MiB;
constexpr size_t WO_W13A = 0, WO_W2A = 11534336, WO_W13B = 17301504, WO_W2B = 28835840, WO_WINA = 34603008, WO_WINB = 41418752, WO_PW = 51904512, WO_WBP = 52428800, WO_WBS = 54525952, WO_WO = 58720256;
constexpr size_t WS_H = 60 * MiB, WS_RA = 132 * MiB, WS_RB = 348 * MiB, WS_DT = 492 * MiB, WS_D2 = 501 * MiB, WS_END = 509 * MiB;
constexpr int NA_ROWS = 3328, NB_ROWS = 5120;
constexpr size_t RA_Z = 0, RA_U = 0, RA_GA = 72 * MiB, RA_GB = 144 * MiB, RA_MG = RA_U;
constexpr size_t RA_XH = 0, RA_BG = (size_t)32 * 36864 * 64 * 2, RA_CG = RA_BG + (size_t)4 * 36864 * 128 * 2;
constexpr size_t OUT_SF = (size_t)T_ALL * DM, OUT_SB = OUT_SF + 16 * 2 * 32 * 64 * 128;

__device__ __forceinline__ unsigned f2bf(float f) { unsigned u = __float_as_uint(f); return (u + 0x7fffu + ((u >> 16) & 1u)) >> 16; }
__device__ __forceinline__ unsigned pk2(float lo, float hi) { return pg8::cvt_pk_bf16(lo, hi); }
__device__ __forceinline__ float blo(unsigned u) { return __uint_as_float(u << 16); }
__device__ __forceinline__ float bhi(unsigned u) { return __uint_as_float(u & 0xffff0000u); }
__device__ __forceinline__ float wave_sum(float v) {
#pragma unroll
    for (int o = 1; o < 64; o <<= 1) v += __shfl_xor(v, o);
    return v;
}
__device__ __forceinline__ float silu_f(float v) { return v * __builtin_amdgcn_rcpf(1.0f + fexp(-v)); }

struct Args {
    const float* in[26];
    float* out; unsigned char* ws;
};

__device__ __forceinline__ void transpose_item(const float* W, int ldw, int K, bf16* WT, int n0, int c0, int k0, LAS float* scr, int lane, const float* kscale = nullptr) {
    const int c = lane & 7;
    if (c0 < 0) {
#pragma unroll
        for (int j = 0; j < 4; ++j) { const int n = (lane >> 3) + 8 * j; *(u32x4*)(WT + (size_t)(n0 + n) * K + k0 + 8 * c) = (u32x4){0u, 0u, 0u, 0u}; }
        return;
    }
    float wv[32];
#pragma unroll
    for (int i = 0; i < 32; ++i) { const int kk = 2 * i + (lane >> 5); wv[i] = W[(size_t)(k0 + kk) * ldw + c0 + (lane & 31)]; if (kscale) wv[i] *= kscale[k0 + kk]; }
#pragma unroll
    for (int i = 0; i < 32; ++i) { const int kk = 2 * i + (lane >> 5); scr[kk * 33 + (lane & 31)] = wv[i]; }
    asm volatile("s_waitcnt lgkmcnt(0)" ::: "memory");
#pragma unroll
    for (int j = 0; j < 4; ++j) { const int n = (lane >> 3) + 8 * j; const LAS float* s = scr + (8 * c) * 33 + n;
        u32x4 o; o.x = pk2(s[0 * 33], s[1 * 33]); o.y = pk2(s[2 * 33], s[3 * 33]); o.z = pk2(s[4 * 33], s[5 * 33]); o.w = pk2(s[6 * 33], s[7 * 33]);
        *(u32x4*)(WT + (size_t)(n0 + n) * K + k0 + 8 * c) = o; }
    asm volatile("s_waitcnt lgkmcnt(0)" ::: "memory");
}
__device__ __forceinline__ void convert_phase(const Args& a, int l, LAS unsigned char* lds, int gw, int ngw, int wave, int lane) {
    size_t wz_ = 0; asm volatile("" : "+s"(wz_)); unsigned char* wsb = a.ws + wz_;
    { unsigned z_ = 0; asm volatile("" : "+s"(z_)); lds += z_; }
    LAS float* scr = (LAS float*)(lds + wave * 8448);
    unsigned char* wb = wsb + WS_W;
    constexpr int I13 = 16 * 176, I2 = 44 * 32, IA = 16 * 104, IB = 16 * 160, IPW = 128, IBP = 16 * 32, IBS = 32 * 32, IWO = 16 * 32;
    constexpr int NITEMS = 2 * I13 + 2 * I2 + IA + IB + IPW + IBP + IBS + IWO;
    for (int it = gw; it < NITEMS; it += ngw) {
        int r = it;
        if (r < 2 * I13) { const int which = r / I13; r -= which * I13; const int kb = r / 176, nb = r % 176, n0 = nb * 32, tile = n0 >> 8, j0 = n0 & 255;
            const int c0 = j0 < 128 ? 128 * tile + j0 : DFF + 128 * tile + (j0 - 128);
            transpose_item(a.in[which ? 11 : 9] + (size_t)l * DM * 2 * DFF, 2 * DFF, DM, (bf16*)(wb + (which ? WO_W13B : WO_W13A)), n0, c0, kb * 64, scr, lane); continue; }
        r -= 2 * I13;
        if (r < 2 * I2) { const int which = r / I2; r -= which * I2; const int kb = r / 32, nb = r % 32;
            transpose_item(a.in[which ? 12 : 10] + (size_t)l * DFF * DM, DM, DFF, (bf16*)(wb + (which ? WO_W2B : WO_W2A)), nb * 32, nb * 32, kb * 64, scr, lane); continue; }
        r -= 2 * I2;
        const float* win = a.in[13] + (size_t)l * DM * 8256;
        if (r < IA) { const int kb = r / 104, nb = r % 104, n0 = nb * 32; const int c0 = n0 < 3136 ? 3072 + n0 : -1;
            transpose_item(win, 8256, DM, (bf16*)(wb + WO_WINA), n0, c0, kb * 64, scr, lane); continue; }
        r -= IA;
        if (r < IB) { const int kb = r / 160, nb = r % 160, n0 = nb * 32; const int c0 = n0 < 2048 ? 1024 + n0 : (n0 < 3072 ? n0 - 2048 : n0 + 3136);
            transpose_item(win, 8256, DM, (bf16*)(wb + WO_WINB), n0, c0, kb * 64, scr, lane); continue; }
        r -= IB;
        if (r < IPW) { const int g = r / 32; r -= g * 32; const int kb = r / 8, nb = r % 8;
            transpose_item(a.in[14] + (size_t)(l * 4 + g) * 65536, 256, 256, (bf16*)(wb + WO_PW) + (size_t)g * 65536, nb * 32, nb * 32, kb * 64, scr, lane); continue; }
        r -= IPW;
        if (r < IBP) { const int kb = r / 32, nb = r % 32;
            transpose_item(a.in[22] + (size_t)l * DM * DM, DM, DM, (bf16*)(wb + WO_WBP), nb * 32, nb * 32, kb * 64, scr, lane); continue; }
        r -= IBP;
        if (r < IBS) { const int kb = r / 32, nb = r % 32;
            transpose_item(a.in[23] + (size_t)l * DIN * DM, DM, DIN, (bf16*)(wb + WO_WBS), nb * 32, nb * 32, kb * 64, scr, lane, a.in[21] + (size_t)l * DIN); continue; }
        r -= IBS;
        { const int kb = r / 32, nb = r % 32;
            transpose_item(a.in[24] + (size_t)l * DM * DM, DM, DM, (bf16*)(wb + WO_WO), nb * 32, nb * 32, kb * 64, scr, lane); }
    }
}
__device__ __forceinline__ void adaln_phase(const Args& a, LAS unsigned char* lds, int tid) {
    size_t wz_ = 0; asm volatile("" : "+s"(wz_)); unsigned char* wsb = a.ws + wz_;
    { unsigned z_ = 0; asm volatile("" : "+s"(z_)); lds += z_; }
    LAS float* sc = (LAS float*)lds;
    LAS float* red = (LAS float*)(lds + 36864);
    float* MOD = (float*)(wsb + WS_MOD);
    if ((int)blockIdx.x >= 288) return;
    for (int i = tid; i < 9 * 1024; i += NTHR) { const int r = i >> 10, k = i & 1023; const float v = r == 0 ? a.in[5][k] : a.in[4][(r - 1) * 1024 + k]; sc[i] = silu_f(v); }
    __syncthreads();
    const int cgp = tid & 15, kc = tid >> 4;
    for (int item = blockIdx.x; item < 288; item += gridDim.x) {
        const int l = item / 144, cgi = item % 144, col0 = cgi * 64 + 4 * cgp;
        const float* w = a.in[6] + ((size_t)l * 1024 + kc * 32) * 9216 + col0;
        f32x4 acc[9];
#pragma unroll
        for (int r = 0; r < 9; ++r) acc[r] = (f32x4){0.f, 0.f, 0.f, 0.f};
#pragma unroll 16
        for (int i = 0; i < 32; ++i) { const f32x4 w4 = *(const f32x4*)(w + (size_t)i * 9216);
#pragma unroll
            for (int r = 0; r < 9; ++r) acc[r] += w4 * sc[r * 1024 + kc * 32 + i]; }
#pragma unroll
        for (int r = 0; r < 9; ++r) *(LAS f32x4*)(red + (kc * 9 + r) * 64 + 4 * cgp) = acc[r];
        __syncthreads();
        for (int o = tid; o < 576; o += NTHR) { const int r = o >> 6, c = o & 63; float s = 0.f;
#pragma unroll 8
            for (int k = 0; k < 32; ++k) s += red[(k * 9 + r) * 64 + c];
            MOD[((size_t)l * 9 + r) * 9216 + cgi * 64 + c] = s + a.in[7][(size_t)l * 9216 + cgi * 64 + c]; }
        __syncthreads();
    }
}
__device__ __forceinline__ void normmod_phase(const Args& a, int l, int idx, bool use_in, bool has_d2, int gw, int ngw, int lane) {
    size_t wz_ = 0; asm volatile("" : "+s"(wz_)); unsigned char* wsb = a.ws + wz_;
    const float* MOD = (const float*)(wsb + WS_MOD) + (size_t)l * 9 * 9216;
    bf16* XB = (bf16*)a.out; bf16* H = (bf16*)(wsb + WS_H); const bf16* D2 = (const bf16*)(wsb + WS_D2);
    const float* gp = a.in[8] + ((size_t)l * 3 + idx) * DM;
    f32x4 gv[2][2];
#pragma unroll
    for (int j = 0; j < 2; ++j) { gv[j][0] = *(const f32x4*)(gp + 8 * (lane + 64 * j)); gv[j][1] = *(const f32x4*)(gp + 8 * (lane + 64 * j) + 4); }
    constexpr int R = 3;
    const int rpw = (((T_ALL + ngw - 1) / ngw + R - 1) / R) * R;
    const int rbeg = gw * rpw, rend = min(rbeg + rpw, T_ALL);
    int cur_mrow = -1; f32x4 gsc[2][2], shv[2][2];
#pragma unroll
    for (int j = 0; j < 2; ++j) { gsc[j][0] = gv[j][0]; gsc[j][1] = gv[j][1]; shv[j][0] = gv[j][0]; shv[j][1] = gv[j][1]; }
    for (int r0 = rbeg; r0 < rend; r0 += R) {
        f32x4 v[R][2][2]; float s[R];
        if (use_in) {
#pragma unroll
            for (int r = 0; r < R; ++r) { const int row = r0 + r;
                const float* srcp = row < T_CTX ? a.in[0] + (size_t)row * DM : a.in[1] + (size_t)(row - T_CTX) * DM;
#pragma unroll
                for (int j = 0; j < 2; ++j) { v[r][j][0] = *(const f32x4*)(srcp + 8 * (lane + 64 * j)); v[r][j][1] = *(const f32x4*)(srcp + 8 * (lane + 64 * j) + 4); } }
        } else {
            u32x4 q[R][2];
#pragma unroll
            for (int r = 0; r < R; ++r)
#pragma unroll
                for (int j = 0; j < 2; ++j) q[r][j] = *(const u32x4*)(XB + (size_t)(r0 + r) * DM + 8 * (lane + 64 * j));
#pragma unroll
            for (int r = 0; r < R; ++r)
#pragma unroll
                for (int j = 0; j < 2; ++j) { v[r][j][0] = (f32x4){blo(q[r][j].x), bhi(q[r][j].x), blo(q[r][j].y), bhi(q[r][j].y)}; v[r][j][1] = (f32x4){blo(q[r][j].z), bhi(q[r][j].z), blo(q[r][j].w), bhi(q[r][j].w)}; }
            if (has_d2 && r0 + R - 1 >= 32768) {
#pragma unroll
                for (int r = 0; r < R; ++r) { const int row = r0 + r;
                    if (row >= 32768) {
#pragma unroll
                        for (int j = 0; j < 2; ++j) { const u32x4 d = *(const u32x4*)(D2 + (size_t)(row - 32768) * DM + 8 * (lane + 64 * j));
                            v[r][j][0] += (f32x4){blo(d.x), bhi(d.x), blo(d.y), bhi(d.y)}; v[r][j][1] += (f32x4){blo(d.z), bhi(d.z), blo(d.w), bhi(d.w)};
                            u32x4 w; w.x = pk2(v[r][j][0].x, v[r][j][0].y); w.y = pk2(v[r][j][0].z, v[r][j][0].w); w.z = pk2(v[r][j][1].x, v[r][j][1].y); w.w = pk2(v[r][j][1].z, v[r][j][1].w);
                            *(u32x4*)(XB + (size_t)row * DM + 8 * (lane + 64 * j)) = w;
                            v[r][j][0] = (f32x4){blo(w.x), bhi(w.x), blo(w.y), bhi(w.y)}; v[r][j][1] = (f32x4){blo(w.z), bhi(w.z), blo(w.w), bhi(w.w)}; } } }
            }
        }
#pragma unroll
        for (int r = 0; r < R; ++r) { s[r] = 0.f;
#pragma unroll
            for (int j = 0; j < 2; ++j)
#pragma unroll
                for (int h = 0; h < 2; ++h) s[r] += (v[r][j][h].x * v[r][j][h].x + v[r][j][h].y * v[r][j][h].y) + (v[r][j][h].z * v[r][j][h].z + v[r][j][h].w * v[r][j][h].w); }
#pragma unroll
        for (int o = 1; o < 64; o <<= 1) {
#pragma unroll
            for (int r = 0; r < R; ++r) s[r] += __shfl_xor(s[r], o); }
#pragma unroll
        for (int r = 0; r < R; ++r) { const int row = r0 + r;
            const int mrow = row < T_CTX ? 0 : 1 + ((row - T_CTX) >> 12);
            if (mrow != cur_mrow) {
                cur_mrow = mrow;
                const float* sh = MOD + (size_t)mrow * 9216 + (3 * idx) * DM;
                const float* scl = MOD + (size_t)mrow * 9216 + (3 * idx + 1) * DM;
#pragma unroll
                for (int j = 0; j < 2; ++j)
#pragma unroll
                    for (int h = 0; h < 2; ++h) { gsc[j][h] = gv[j][h] * (*(const f32x4*)(scl + 8 * (lane + 64 * j) + 4 * h) + 1.0f); shv[j][h] = *(const f32x4*)(sh + 8 * (lane + 64 * j) + 4 * h); }
            }
            const float rstd = __builtin_amdgcn_rsqf((s[r] + EPS * DM) * (1.f / DM));
#pragma unroll
            for (int j = 0; j < 2; ++j) { const f32x4 h0 = (v[r][j][0] * rstd) * gsc[j][0] + shv[j][0], h1 = (v[r][j][1] * rstd) * gsc[j][1] + shv[j][1];
                u32x4 w; w.x = pk2(h0.x, h0.y); w.y = pk2(h0.z, h0.w); w.z = pk2(h1.x, h1.y); w.w = pk2(h1.z, h1.w);
                *(u32x4*)(H + (size_t)row * DM + 8 * (lane + 64 * j)) = w; } }
    }
}
__device__ __forceinline__ void final_norm_phase(const Args& a, bool has_d2, int gw, int ngw, int lane) {
    size_t wz_ = 0; asm volatile("" : "+s"(wz_)); unsigned char* wsb = a.ws + wz_;
    float* OUT = a.out; const bf16* XW = (const bf16*)(wsb + WS_RB); const bf16* D2 = (const bf16*)(wsb + WS_D2);
    const float* gp = a.in[25];
    f32x4 gv[2][2];
#pragma unroll
    for (int j = 0; j < 2; ++j) { gv[j][0] = *(const f32x4*)(gp + 8 * (lane + 64 * j)); gv[j][1] = *(const f32x4*)(gp + 8 * (lane + 64 * j) + 4); }
    constexpr int R = 3;
    for (int r0 = gw * R; r0 < T_ALL; r0 += ngw * R) {
        u32x4 q[R][2]; f32x4 v[R][2][2]; float s[R];
#pragma unroll
        for (int r = 0; r < R; ++r)
#pragma unroll
            for (int j = 0; j < 2; ++j) q[r][j] = *(const u32x4*)(XW + (size_t)(r0 + r) * DM + 8 * (lane + 64 * j));
#pragma unroll
        for (int r = 0; r < R; ++r)
#pragma unroll
            for (int j = 0; j < 2; ++j) { v[r][j][0] = (f32x4){blo(q[r][j].x), bhi(q[r][j].x), blo(q[r][j].y), bhi(q[r][j].y)}; v[r][j][1] = (f32x4){blo(q[r][j].z), bhi(q[r][j].z), blo(q[r][j].w), bhi(q[r][j].w)}; }
        if (has_d2 && r0 + R - 1 >= 32768) {
#pragma unroll
            for (int r = 0; r < R; ++r) if (r0 + r >= 32768) {
#pragma unroll
                for (int j = 0; j < 2; ++j) { const u32x4 d = *(const u32x4*)(D2 + (size_t)(r0 + r - 32768) * DM + 8 * (lane + 64 * j));
                    v[r][j][0] += (f32x4){blo(d.x), bhi(d.x), blo(d.y), bhi(d.y)}; v[r][j][1] += (f32x4){blo(d.z), bhi(d.z), blo(d.w), bhi(d.w)}; } }
        }
#pragma unroll
        for (int r = 0; r < R; ++r) { s[r] = 0.f;
#pragma unroll
            for (int j = 0; j < 2; ++j)
#pragma unroll
                for (int h = 0; h < 2; ++h) s[r] += (v[r][j][h].x * v[r][j][h].x + v[r][j][h].y * v[r][j][h].y) + (v[r][j][h].z * v[r][j][h].z + v[r][j][h].w * v[r][j][h].w); }
#pragma unroll
        for (int o = 1; o < 64; o <<= 1) {
#pragma unroll
            for (int r = 0; r < R; ++r) s[r] += __shfl_xor(s[r], o); }
#pragma unroll
        for (int r = 0; r < R; ++r) { const float rstd = __builtin_amdgcn_rsqf((s[r] + EPS * DM) * (1.f / DM)); float* orow = OUT + (size_t)(r0 + r) * DM;
#pragma unroll
            for (int j = 0; j < 2; ++j) { *(f32x4*)(orow + 8 * (lane + 64 * j)) = v[r][j][0] * rstd * gv[j][0]; *(f32x4*)(orow + 8 * (lane + 64 * j) + 4) = v[r][j][1] * rstd * gv[j][1]; } }
    }
}
__device__ __forceinline__ void unpack8(const u32x4 q, float (&f)[8]) { f[0] = blo(q.x); f[1] = bhi(q.x); f[2] = blo(q.y); f[3] = bhi(q.y); f[4] = blo(q.z); f[5] = bhi(q.z); f[6] = blo(q.w); f[7] = bhi(q.w); }
__device__ __forceinline__ u32x4 pack8(const float (&f)[8]) { u32x4 w; w.x = pk2(f[0], f[1]); w.y = pk2(f[2], f[3]); w.z = pk2(f[4], f[5]); w.w = pk2(f[6], f[7]); return w; }
__device__ __forceinline__ void conv_phase(const Args& a, int l, int t_begin, int t_count, int raw_off, int gw, int ngw, int lane) {
    size_t wz_ = 0; asm volatile("" : "+s"(wz_)); unsigned char* wsb = a.ws + wz_;
    const bf16* RAW = (const bf16*)(wsb + WS_RB); bf16* XH = (bf16*)(wsb + WS_RA + RA_XH); bf16* BG = (bf16*)(wsb + WS_RA + RA_BG); bf16* CG = (bf16*)(wsb + WS_RA + RA_CG);
    const int nitems = (t_count / 16) * 6;
    int convd = CONVD; asm volatile("" : "+s"(convd));
    for (int it = gw; it < nitems; it += ngw) {
        const int cb = it % 6, run = it / 6, t0 = t_begin + run * 16, ch = cb * 512 + lane * 8;
        int s0, e0; if (t0 < T_CTX) { s0 = t0 & ~255; e0 = s0 + 256; } else { s0 = T_CTX + ((t0 - T_CTX) & ~4095); e0 = s0 + 4096; }
        float w[4][8], b[8];
#pragma unroll
        for (int k = 0; k < 4; ++k) { const f32x4 w0 = *(const f32x4*)(a.in[16] + ((size_t)l * 4 + k) * CONVD + ch), w1 = *(const f32x4*)(a.in[16] + ((size_t)l * 4 + k) * CONVD + ch + 4);
            w[k][0] = w0.x; w[k][1] = w0.y; w[k][2] = w0.z; w[k][3] = w0.w; w[k][4] = w1.x; w[k][5] = w1.y; w[k][6] = w1.z; w[k][7] = w1.w; }
        { const f32x4 b0 = *(const f32x4*)(a.in[17] + (size_t)l * CONVD + ch), b1 = *(const f32x4*)(a.in[17] + (size_t)l * CONVD + ch + 4);
            b[0] = b0.x; b[1] = b0.y; b[2] = b0.z; b[3] = b0.w; b[4] = b1.x; b[5] = b1.y; b[6] = b1.z; b[7] = b1.w; }
        bf16* dst; int dstride;
        if (ch < 2048) { dst = XH + (size_t)(ch >> 6) * T_ALL * 64 + (ch & 63); dstride = 64; }
        else if (ch < 2560) { dst = BG + (size_t)((ch - 2048) >> 7) * T_ALL * 128 + ((ch - 2048) & 127); dstride = 128; }
        else { dst = CG + (size_t)((ch - 2560) >> 7) * T_ALL * 128 + ((ch - 2560) & 127); dstride = 128; }
        u32x4 rw[19];
#pragma unroll
        for (int i = 0; i < 19; ++i) { const int t = t0 - 2 + i; rw[i] = (t >= s0 && t < e0) ? *(const u32x4*)(RAW + (size_t)(t - t_begin + raw_off) * convd + ch) : (u32x4){0u, 0u, 0u, 0u}; }
        float xm2[8], xm1[8], x0[8], xp1[8];
        unpack8(rw[0], xm2); unpack8(rw[1], xm1); unpack8(rw[2], x0);
#pragma unroll
        for (int i = 0; i < 16; ++i) {
            unpack8(rw[i + 3], xp1);
            float o[8];
#pragma unroll
            for (int c = 0; c < 8; ++c) { const float v = b[c] + w[0][c] * xm2[c] + w[1][c] * xm1[c] + w[2][c] * x0[c] + w[3][c] * xp1[c]; o[c] = silu_f(v); }
            *(u32x4*)(dst + (size_t)(t0 + i) * dstride) = pack8(o);
#pragma unroll
            for (int c = 0; c < 8; ++c) { xm2[c] = xm1[c]; xm1[c] = x0[c]; x0[c] = xp1[c]; }
        }
    }
}
template <int W>
__device__ __forceinline__ void hpool_g(const bf16* U, bf16* HS, int g, int gt, int ngt) {
    const int n = T_ALL * 32;
    for (int i = gt; i < n; i += ngt) {
        const int t = i >> 5, chunk = g * 32 + (i & 31);
        const bool ctx = t < T_CTX;
        const int c = ctx ? (t & 255) : ((t - T_CTX) & 63), lim = ctx ? 256 : 64;
        u32x4 q[W];
#pragma unroll
        for (int j = 0; j < W; ++j) { const int cc = c - W / 2 + j; const bool ok = (unsigned)cc < (unsigned)lim;
            q[j] = ok ? *(const u32x4*)(U + (size_t)(t - c + cc) * DM + chunk * 8) : (u32x4){0u, 0u, 0u, 0u}; }
        float s[8] = {0.f, 0.f, 0.f, 0.f, 0.f, 0.f, 0.f, 0.f};
#pragma unroll
        for (int j = 0; j < W; ++j) { float f[8]; unpack8(q[j], f);
#pragma unroll
            for (int k = 0; k < 8; ++k) s[k] += f[k]; }
        *(u32x4*)(HS + (size_t)t * DM + chunk * 8) = pack8(s);
    }
}
__device__ __forceinline__ void hpool_phase(const Args& a, int gt, int ngt) {
    size_t wz_ = 0; asm volatile("" : "+s"(wz_)); unsigned char* wsb = a.ws + wz_;
    const bf16* U = (const bf16*)(wsb + WS_RA + RA_U); bf16* HS = (bf16*)(wsb + WS_H);
    hpool_g<2>(U, HS, 0, gt, ngt); hpool_g<4>(U, HS, 1, gt, ngt); hpool_g<8>(U, HS, 2, gt, ngt); hpool_g<16>(U, HS, 3, gt, ngt);
}
template <int W>
__device__ __forceinline__ void vpool_g(bf16* U, const bf16* HS, int g, int gt, int ngt) {
    const int n = T_ALL * 32;
    for (int i = gt; i < n; i += ngt) {
        const int t = i >> 5, chunk = g * 32 + (i & 31);
        float s[8] = {0.f, 0.f, 0.f, 0.f, 0.f, 0.f, 0.f, 0.f}; float cnt;
        if (t < T_CTX) {
            const int p = t & 255;
            unpack8(*(const u32x4*)(HS + (size_t)t * DM + chunk * 8), s);
            cnt = (float)(min(p - W / 2 + W, 256) - max(p - W / 2, 0));
        } else {
            const int pos = (t - T_CTX) & 4095, c = pos & 63, r = pos >> 6;
            u32x4 q[W];
#pragma unroll
            for (int j = 0; j < W; ++j) { const int rr = r - W / 2 + j; const bool ok = (unsigned)rr < 64u;
                q[j] = ok ? *(const u32x4*)(HS + (size_t)(t + (rr - r) * 64) * DM + chunk * 8) : (u32x4){0u, 0u, 0u, 0u}; }
#pragma unroll
            for (int j = 0; j < W; ++j) { float f[8]; unpack8(q[j], f);
#pragma unroll
                for (int k = 0; k < 8; ++k) s[k] += f[k]; }
            cnt = (float)((min(r - W / 2 + W, 64) - max(r - W / 2, 0)) * (min(c - W / 2 + W, 64) - max(c - W / 2, 0)));
        }
        float u[8]; unpack8(*(const u32x4*)(U + (size_t)t * DM + chunk * 8), u);
        const float inv = 1.0f / cnt;
#pragma unroll
        for (int k = 0; k < 8; ++k) s[k] = s[k] * inv - u[k];
        *(u32x4*)(U + (size_t)t * DM + chunk * 8) = pack8(s);
    }
}
__device__ __forceinline__ void vpool_phase(const Args& a, int gt, int ngt) {
    size_t wz_ = 0; asm volatile("" : "+s"(wz_)); unsigned char* wsb = a.ws + wz_;
    bf16* U = (bf16*)(wsb + WS_RA + RA_U); const bf16* HS = (const bf16*)(wsb + WS_H);
    vpool_g<2>(U, HS, 0, gt, ngt); vpool_g<4>(U, HS, 1, gt, ngt); vpool_g<8>(U, HS, 2, gt, ngt); vpool_g<16>(U, HS, 3, gt, ngt);
}
__device__ __forceinline__ void gatednorm_phase(const Args& a, int l, int gw, int ngw, int lane) {
    const bf16* Z = (const bf16*)(a.ws + WS_RA + RA_Z); bf16* Y = (bf16*)(a.ws + WS_RB);
    const float* g = a.in[21] + (size_t)l * DIN;
    constexpr int R = 2;
    for (int t0 = gw * R; t0 < T_ALL; t0 += ngw * R) {
        u32x4 yq[R][4], zq[R][4];
#pragma unroll
        for (int r = 0; r < R; ++r) { const bf16* yr = Y + (size_t)(t0 + r) * DIN; const bf16* zr = Z + (size_t)(t0 + r) * DIN;
#pragma unroll
            for (int j = 0; j < 4; ++j) { yq[r][j] = *(const u32x4*)(yr + (j * 64 + lane) * 8); zq[r][j] = *(const u32x4*)(zr + (j * 64 + lane) * 8); } }
        float s[R];
#pragma unroll
        for (int r = 0; r < R; ++r) { s[r] = 0.f;
#pragma unroll
            for (int j = 0; j < 4; ++j) { float y[8], z[8]; unpack8(yq[r][j], y); unpack8(zq[r][j], z);
#pragma unroll
                for (int k = 0; k < 8; ++k) { y[k] = y[k] * silu_f(z[k]); s[r] += y[k] * y[k]; }
                yq[r][j] = (u32x4){__float_as_uint(y[0]), __float_as_uint(y[1]), __float_as_uint(y[2]), __float_as_uint(y[3])};
                zq[r][j] = (u32x4){__float_as_uint(y[4]), __float_as_uint(y[5]), __float_as_uint(y[6]), __float_as_uint(y[7])}; } }
#pragma unroll
        for (int o = 1; o < 64; o <<= 1) {
#pragma unroll
            for (int r = 0; r < R; ++r) s[r] += __shfl_xor(s[r], o); }
#pragma unroll
        for (int r = 0; r < R; ++r) { const float rstd = __builtin_amdgcn_rsqf(s[r] * (1.f / DIN) + EPS); bf16* yr = Y + (size_t)(t0 + r) * DIN;
#pragma unroll
            for (int j = 0; j < 4; ++j) { const f32x4 g0 = *(const f32x4*)(g + (j * 64 + lane) * 8), g1 = *(const f32x4*)(g + (j * 64 + lane) * 8 + 4);
                float o[8] = {__uint_as_float(yq[r][j].x) * rstd * g0.x, __uint_as_float(yq[r][j].y) * rstd * g0.y, __uint_as_float(yq[r][j].z) * rstd * g0.z, __uint_as_float(yq[r][j].w) * rstd * g0.w,
                              __uint_as_float(zq[r][j].x) * rstd * g1.x, __uint_as_float(zq[r][j].y) * rstd * g1.y, __uint_as_float(zq[r][j].z) * rstd * g1.z, __uint_as_float(zq[r][j].w) * rstd * g1.w};
                *(u32x4*)(yr + (j * 64 + lane) * 8) = pack8(o); } }
    }
}
constexpr int RS_BC = 272, RS_X = 160;
constexpr int L_BI = 0, L_CI = 34816, L_XI = 69632, L_HI = 90112, L_CS = 110592, L_DTV = L_CS + 512, L_WV = L_CS + 1024, L_TOT = L_CS + 1536;
__device__ __forceinline__ s16x4 trd(LAS unsigned char* p) { return __builtin_amdgcn_ds_read_tr16_b64_v4i16((LAS s16x4*)p); }
__device__ __forceinline__ bf16x8 cat4(s16x4 a, s16x4 b) { return (bf16x8){a[0], a[1], a[2], a[3], b[0], b[1], b[2], b[3]}; }
#define MFMA16(A, B, C) __builtin_amdgcn_mfma_f32_16x16x32_bf16((A), (B), (C), 0, 0, 0)

template <bool BWD>
__device__ __forceinline__ void ssd_sweep(LAS unsigned char* lds, const bf16* XH, const bf16* BG, const bf16* CG, const float* DT, bf16* YH, int tok0, int nc, int h, float aneg, float dskip,
                                          const float* h0, float* hout, int tid, int wave, int lane) {
    const int lt = wave < 4 ? wave : 11 - wave;
    const int grp = h >> 3, dcol = (BWD ? 32 : 0) + h, scanw = BWD ? 4 : 0;
    const int cl = lane & 15, g = lane >> 4, q4 = (lane & 15) >> 2, pp = lane & 3;
    const int lcol = 16 * lt + cl;
    f32x4 hacc[4];
#pragma unroll
    for (int pt = 0; pt < 4; ++pt)
#pragma unroll
        for (int j = 0; j < 4; ++j) hacc[pt][j] = h0 ? h0[(size_t)(16 * pt + 4 * g + j) * 128 + lcol] : 0.f;
    u32x4 st[10]; float dts0 = 0.f, dts1 = 0.f; u32x2 yprev[4] = {(u32x2){0u, 0u}, (u32x2){0u, 0u}, (u32x2){0u, 0u}, (u32x2){0u, 0u}};
#define SSD_SB() __builtin_amdgcn_sched_barrier(0)
#define SSD_LOAD_CHUNK(c_) do { const int tokc_ = tok0 + (c_) * 128; \
        _Pragma("unroll") for (int r = 0; r < 2; ++r) { const int q = tid + 512 * r, row = q >> 3, c16 = q & 7; st[r] = *(const u32x4*)(XH + ((size_t)h * T_ALL + tokc_ + row) * 64 + c16 * 8); } \
        _Pragma("unroll") for (int r = 0; r < 4; ++r) { const int q = tid + 512 * r, row = q >> 4, c16 = q & 15; st[2 + r] = *(const u32x4*)(BG + ((size_t)grp * T_ALL + tokc_ + row) * 128 + c16 * 8); } \
        _Pragma("unroll") for (int r = 0; r < 4; ++r) { const int q = tid + 512 * r, row = q >> 4, c16 = q & 15; st[6 + r] = *(const u32x4*)(CG + ((size_t)grp * T_ALL + tokc_ + row) * 128 + c16 * 8); } \
        if (wave == scanw) { dts0 = DT[(size_t)(tokc_ + lane) * 64 + dcol]; dts1 = DT[(size_t)(tokc_ + 64 + lane) * 64 + dcol]; } \
        if (!BWD) { const bf16* yq = YH + (size_t)(tokc_ + lcol) * DIN + h * 64 + 4 * g; _Pragma("unroll") for (int pt = 0; pt < 4; ++pt) yprev[pt] = *(const u32x2*)(yq + 16 * pt); } \
    } while (0)
#define SSD_SCAN(cb_) do { if (wave == scanw) { \
        const float da0 = dts0 * aneg, da1 = dts1 * aneg; float p0 = da0, p1 = da1; \
        _Pragma("unroll") for (int o = 1; o < 64; o <<= 1) { const float t0 = __shfl_up(p0, o), t1 = __shfl_up(p1, o); if (lane >= o) { p0 += t0; p1 += t1; } } \
        const float tot0 = __shfl(p0, 63), tot1 = __shfl(p1, 63), total = tot0 + tot1; p1 += tot0; \
        const float c0 = BWD ? total - p0 + da0 : p0, c1 = BWD ? total - p1 + da1 : p1; \
        LAS float* CS = (LAS float*)(lds + (cb_)); \
        CS[lane] = c0; CS[64 + lane] = c1; CS[128 + lane] = dts0; CS[192 + lane] = dts1; \
        CS[256 + lane] = dts0 * fexp(total - c0); CS[320 + lane] = dts1 * fexp(total - c1); \
        if (lane == 0) CS[384] = total; } } while (0)
    if (BWD ? (wave < 4) : (wave >= 4)) __builtin_amdgcn_s_setprio(2);
    SSD_LOAD_CHUNK(BWD ? nc - 1 : 0);
    SSD_SCAN(L_CS);
    for (int step = 0; step < nc; ++step) {
        const int c = BWD ? nc - 1 - step : step;
        const int tokc = tok0 + c * 128;
        const int csb = L_CS + (step & 1) * 2048;
#pragma unroll
        for (int r = 0; r < 2; ++r) { const int q = tid + 512 * r, row = q >> 3, c16 = q & 7; *(LAS u32x4*)(lds + L_XI + row * RS_X + c16 * 16) = st[r]; }
#pragma unroll
        for (int r = 0; r < 4; ++r) { const int q = tid + 512 * r, row = q >> 4, c16 = q & 15; *(LAS u32x4*)(lds + L_BI + row * RS_BC + c16 * 16) = st[2 + r]; }
#pragma unroll
        for (int r = 0; r < 4; ++r) { const int q = tid + 512 * r, row = q >> 4, c16 = q & 15; *(LAS u32x4*)(lds + L_CI + row * RS_BC + c16 * 16) = st[6 + r]; }
#pragma unroll
        for (int pt = 0; pt < 4; ++pt) { u32x2 w; w.x = pk2(hacc[pt][0], hacc[pt][1]); w.y = pk2(hacc[pt][2], hacc[pt][3]);
            *(LAS u32x2*)(lds + L_HI + lcol * RS_X + (16 * pt + 4 * g) * 2) = w; }
        u32x2 ycur[4];
#pragma unroll
        for (int pt = 0; pt < 4; ++pt) ycur[pt] = yprev[pt];
        if (step + 1 < nc) SSD_LOAD_CHUNK(BWD ? c - 1 : c + 1);
        __syncthreads();
        {
            const float csl = *(LAS float*)(lds + csb + lcol * 4);
            bf16x8 cf[4];
#pragma unroll
            for (int k = 0; k < 4; ++k) cf[k] = *(LAS bf16x8*)(lds + L_CI + lcol * RS_BC + (32 * k + 8 * g) * 2);
            f32x4 yacc[4];
#pragma unroll
            for (int pt = 0; pt < 4; ++pt) yacc[pt] = (f32x4){0.f, 0.f, 0.f, 0.f};
            bf16x8 hf[2][4];
#define SSD_LD_H(buf_, k_) do { _Pragma("unroll") for (int pt = 0; pt < 4; ++pt) { LAS unsigned char* p0 = lds + L_HI + (32 * (k_) + 8 * g + q4) * RS_X + (16 * pt) * 2 + 8 * pp; \
                hf[buf_][pt] = cat4(trd(p0), trd(p0 + 4 * RS_X)); } } while (0)
            SSD_LD_H(0, 0);
            SSD_SB();
#pragma unroll
            for (int k = 0; k < 4; ++k) {
                if (k < 3) SSD_LD_H((k + 1) & 1, k + 1);
#pragma unroll
                for (int pt = 0; pt < 4; ++pt) yacc[pt] = MFMA16(hf[k & 1][pt], cf[k], yacc[pt]);
                SSD_SB();
            }
            const float el = fexp(csl);
#pragma unroll
            for (int pt = 0; pt < 4; ++pt) yacc[pt] *= el;
#pragma unroll 1
            for (int sb = 0; sb < 4; ++sb) {
                const bool need = BWD ? (2 * sb + 1 >= lt) : (2 * sb <= lt);
                if (!need) continue;
                bf16x8 ba[2][4]; f32x4 css[2], dtv[2]; bf16x8 xa[4];
#pragma unroll
                for (int u = 0; u < 2; ++u) {
#pragma unroll
                    for (int k = 0; k < 4; ++k) ba[u][k] = *(LAS bf16x8*)(lds + L_BI + (32 * sb + 16 * u + cl) * RS_BC + (32 * k + 8 * g) * 2);
                    css[u] = *(LAS f32x4*)(lds + csb + (32 * sb + 16 * u + 4 * g) * 4); dtv[u] = *(LAS f32x4*)(lds + csb + 512 + (32 * sb + 16 * u + 4 * g) * 4); }
#pragma unroll
                for (int pt = 0; pt < 4; ++pt) { LAS unsigned char* p0 = lds + L_XI + (32 * sb + 4 * g + q4) * RS_X + (16 * pt) * 2 + 8 * pp; xa[pt] = cat4(trd(p0), trd(p0 + 16 * RS_X)); }
                SSD_SB();
                f32x4 sacc[2] = {(f32x4){0.f, 0.f, 0.f, 0.f}, (f32x4){0.f, 0.f, 0.f, 0.f}};
#pragma unroll
                for (int k = 0; k < 4; ++k) { sacc[0] = MFMA16(ba[0][k], cf[k], sacc[0]); sacc[1] = MFMA16(ba[1][k], cf[k], sacc[1]); }
                f32x4 m[2];
#pragma unroll
                for (int u = 0; u < 2; ++u)
#pragma unroll
                    for (int j = 0; j < 4; ++j) { const int s = 32 * sb + 16 * u + 4 * g + j; const bool valid = BWD ? (s >= lcol) : (s <= lcol);
                        float v = valid ? sacc[u][j] * fexp(fminf(csl - css[u][j], 0.f)) * dtv[u][j] : 0.f;
                        if (!BWD && s == lcol) v += dskip;
                        m[u][j] = v; }
                u32x4 mw; mw.x = pk2(m[0][0], m[0][1]); mw.y = pk2(m[0][2], m[0][3]); mw.z = pk2(m[1][0], m[1][1]); mw.w = pk2(m[1][2], m[1][3]);
                const bf16x8 mf = __builtin_bit_cast(bf16x8, mw);
#pragma unroll
                for (int pt = 0; pt < 4; ++pt) yacc[pt] = MFMA16(xa[pt], mf, yacc[pt]);
                SSD_SB();
            }
            bf16* yp = YH + (size_t)(tokc + lcol) * DIN + h * 64 + 4 * g;
#pragma unroll
            for (int pt = 0; pt < 4; ++pt) { f32x4 v = yacc[pt];
                if (!BWD) { v[0] += blo(ycur[pt].x); v[1] += bhi(ycur[pt].x); v[2] += blo(ycur[pt].y); v[3] += bhi(ycur[pt].y); }
                u32x2 w; w.x = pk2(v[0], v[1]); w.y = pk2(v[2], v[3]); *(u32x2*)(yp + 16 * pt) = w; }
            const float dec = fexp(*(LAS float*)(lds + csb + 1536));
#pragma unroll
            for (int pt = 0; pt < 4; ++pt) hacc[pt] *= dec;
            s16x4 sb0[2], sb1[2]; f32x4 sw0[2], sw1[2]; bf16x8 sx[2][4];
#define SSD_LD_S(buf_, k_) do { LAS unsigned char* pb = lds + L_BI + (32 * (k_) + 8 * g + q4) * RS_BC + (16 * lt) * 2 + 8 * pp; \
                sb0[buf_] = trd(pb); sb1[buf_] = trd(pb + 4 * RS_BC); \
                sw0[buf_] = *(LAS f32x4*)(lds + csb + 1024 + (32 * (k_) + 8 * g) * 4); sw1[buf_] = *(LAS f32x4*)(lds + csb + 1024 + (32 * (k_) + 8 * g + 4) * 4); \
                _Pragma("unroll") for (int pt = 0; pt < 4; ++pt) { LAS unsigned char* p0 = lds + L_XI + (32 * (k_) + 8 * g + q4) * RS_X + (16 * pt) * 2 + 8 * pp; sx[buf_][pt] = cat4(trd(p0), trd(p0 + 4 * RS_X)); } } while (0)
            SSD_LD_S(0, 0);
            SSD_SB();
#pragma unroll
            for (int k = 0; k < 4; ++k) {
                if (k < 3) SSD_LD_S((k + 1) & 1, k + 1);
                const s16x4 b0 = sb0[k & 1], b1 = sb1[k & 1]; const f32x4 w0 = sw0[k & 1], w1 = sw1[k & 1];
                u32x4 bw;
                bw.x = pk2(__uint_as_float((unsigned)(unsigned short)b0[0] << 16) * w0[0], __uint_as_float((unsigned)(unsigned short)b0[1] << 16) * w0[1]);
                bw.y = pk2(__uint_as_float((unsigned)(unsigned short)b0[2] << 16) * w0[2], __uint_as_float((unsigned)(unsigned short)b0[3] << 16) * w0[3]);
                bw.z = pk2(__uint_as_float((unsigned)(unsigned short)b1[0] << 16) * w1[0], __uint_as_float((unsigned)(unsigned short)b1[1] << 16) * w1[1]);
                bw.w = pk2(__uint_as_float((unsigned)(unsigned short)b1[2] << 16) * w1[2], __uint_as_float((unsigned)(unsigned short)b1[3] << 16) * w1[3]);
                const bf16x8 bfr = __builtin_bit_cast(bf16x8, bw);
#pragma unroll
                for (int pt = 0; pt < 4; ++pt) hacc[pt] = MFMA16(sx[k & 1][pt], bfr, hacc[pt]);
                SSD_SB();
            }
            if (step + 1 < nc) SSD_SCAN(L_CS + ((step + 1) & 1) * 2048);
        }
        __syncthreads();
    }
    __builtin_amdgcn_s_setprio(0);
#undef SSD_LD_H
#undef SSD_LD_S
#undef SSD_SCAN
#undef SSD_LOAD_CHUNK
#undef SSD_SB
    if (hout) {
#pragma unroll
        for (int pt = 0; pt < 4; ++pt)
#pragma unroll
            for (int j = 0; j < 4; ++j) hout[(size_t)(16 * pt + 4 * g + j) * 128 + lcol] = hacc[pt][j];
    }
}
__device__ __forceinline__ void ssd_phase(const Args& a, int l, LAS unsigned char* lds, int vcu, int G, int tid, int wave, int lane) {
    size_t wz_ = 0; asm volatile("" : "+s"(wz_)); unsigned char* wsb = a.ws + wz_;
    { unsigned z_ = 0; asm volatile("" : "+s"(z_)); lds += z_; }
    const bf16* XH = (const bf16*)(wsb + WS_RA + RA_XH); const bf16* BG = (const bf16*)(wsb + WS_RA + RA_BG); const bf16* CG = (const bf16*)(wsb + WS_RA + RA_CG);
    const float* DT = (const float*)(wsb + WS_DT); bf16* YH = (bf16*)(wsb + WS_RB);
    for (int item = vcu; item < 256 + 512; item += G) {
        int tok0, nc, h; const float *h0f = nullptr, *h0b = nullptr; float *hof = nullptr, *hob = nullptr;
        if (item < 256) { const int b = item >> 5; h = item & 31; tok0 = T_CTX + b * 4096; nc = 32;
            h0f = a.in[2] + ((size_t)(b * 2 + l) * 32 + h) * 8192; h0b = a.in[3] + ((size_t)(b * 2 + l) * 32 + h) * 8192; }
        else { const int i2 = item - 256, b = i2 >> 5; h = i2 & 31; tok0 = b * 256; nc = 2;
            hof = a.out + OUT_SF + ((size_t)(b * 2 + l) * 32 + h) * 8192; hob = a.out + OUT_SB + ((size_t)(b * 2 + l) * 32 + h) * 8192; }
        const float af = -fexp(a.in[18][(size_t)l * 64 + h]), ab = -fexp(a.in[18][(size_t)l * 64 + 32 + h]);
        const float dsk = a.in[20][(size_t)l * 32 + h];
        ssd_sweep<true>(lds, XH, BG, CG, DT, YH, tok0, nc, h, ab, dsk, h0b, hob, tid, wave, lane);
        ssd_sweep<false>(lds, XH, BG, CG, DT, YH, tok0, nc, h, af, dsk, h0f, hof, tid, wave, lane);
    }
}

#define XB_TMO      128
#define XB_XCNT(j)  (256  + 64 * (j))
#define XB_XSUB(j)  (1280 + 64 * (j))
#define XB_XGEN(j)  (2304 + 64 * (j))
#define XB_TOP      3328
#define XB_TOPGEN   3392
#define XCD_BAR_WORDS 3456
#define XB_SPIN_CAP (1u << 18)

__device__ __forceinline__ unsigned xb_ld(unsigned* p)              { return __hip_atomic_load(p, __ATOMIC_RELAXED, __HIP_MEMORY_SCOPE_AGENT); }
__device__ __forceinline__ unsigned xb_add(unsigned* p, unsigned v) { return __hip_atomic_fetch_add(p, v, __ATOMIC_RELAXED, __HIP_MEMORY_SCOPE_AGENT); }
__device__ __forceinline__ unsigned xb_xcc_id() { return (unsigned)__builtin_amdgcn_s_getreg((3 << 11) | 20) & 0xFu; }
#define XB_SPIN(cond, bar) do { unsigned _sp = 0; while (cond) { __builtin_amdgcn_s_sleep(1); \
    if ((++_sp & 255u) == 0u) { if (xb_ld(&(bar)[XB_TMO])) break; if (_sp > XB_SPIN_CAP) { atomicAdd(&(bar)[XB_TMO], 1u); break; } } } } while (0)

struct XcdBarrier {
    unsigned* bar; unsigned x;
    volatile LAS unsigned* st;
};

__device__ __forceinline__ XcdBarrier xcd_barrier_post(unsigned* bar, volatile LAS unsigned* st) {
    XcdBarrier b; b.bar = bar; b.x = xb_xcc_id(); b.st = st;
    if (threadIdx.x == 0) (void)xb_add(&bar[XB_XCNT(b.x)], 1u);
    return b;
}
__device__ __forceinline__ void xcd_barrier_complete(unsigned* bar, unsigned x, unsigned& nloc, unsigned& nx) {
    const unsigned G = gridDim.x * gridDim.y * gridDim.z;
    unsigned sum, cnt, mine, sp = 0u;
    for (;;) {
        sum = 0u; cnt = 0u; mine = 0u;
#pragma unroll 1
        for (unsigned j = 0; j < 16; ++j) { const unsigned c = xb_ld(&bar[XB_XCNT(j)]); sum += c; cnt += (c > 0u) ? 1u : 0u; }
        mine = xb_ld(&bar[XB_XCNT(x)]);
        if (sum == G) break;
        __builtin_amdgcn_s_sleep(1);
        if ((++sp & 255u) == 0u) { if (xb_ld(&bar[XB_TMO])) break; if (sp > XB_SPIN_CAP) { atomicAdd(&bar[XB_TMO], 1u); break; } }
    }
    nloc = mine > 0u ? mine : 1u; nx = cnt > 0u ? cnt : 1u;
}

__device__ __forceinline__ void xcd_barrier(const XcdBarrier& b) {
    asm volatile("s_waitcnt vmcnt(0)" ::: "memory");
    __syncthreads();
    if (threadIdx.x == 0) {
        unsigned* bar = b.bar;
        __builtin_amdgcn_s_waitcnt(0);
        unsigned nloc = b.st[0], nx = b.st[1];
        if (nloc == 0u) { xcd_barrier_complete(bar, b.x, nloc, nx); b.st[0] = nloc; b.st[1] = nx; }
        const unsigned old = xb_add(&bar[XB_XSUB(b.x)], 1u);
        const unsigned gen = old / nloc;
        if (old + 1u == (gen + 1u) * nloc) {
            __builtin_amdgcn_fence(__ATOMIC_RELEASE, "agent");
            asm volatile("s_waitcnt vmcnt(0)" ::: "memory");
            const unsigned og = xb_add(&bar[XB_TOP], 1u);
            const unsigned tg = og / nx;
            if (og + 1u == (tg + 1u) * nx) xb_add(&bar[XB_TOPGEN], 1u);
            else XB_SPIN(xb_ld(&bar[XB_TOPGEN]) == tg, bar);
            __builtin_amdgcn_fence(__ATOMIC_ACQUIRE, "agent");
            xb_add(&bar[XB_XGEN(b.x)], 1u);
            asm volatile("s_waitcnt vmcnt(0)" ::: "memory");
        } else {
            XB_SPIN(xb_ld(&bar[XB_XGEN(b.x)]) == gen, bar);
            __builtin_amdgcn_fence(__ATOMIC_ACQUIRE, "agent");
            asm volatile("s_waitcnt vmcnt(0)" ::: "memory");
        }
    }
    __syncthreads();
}

__global__ void __launch_bounds__(NTHR, 2) hybrid_fwd(Args a) {
    extern __shared__ __attribute__((aligned(16))) unsigned char lds_raw[];
    LAS unsigned char* lds = (LAS unsigned char*)lds_raw;
    cg::grid_group grid = cg::this_grid();
    constexpr int G = 256; const int bid = blockIdx.x;
    const int vcu = (G % 8 == 0) ? (bid % 8) * (G / 8) + bid / 8 : bid;
    const int ngw = G * NWAVES, ngt = G * NTHR;
#define TIDS() int tid = threadIdx.x; asm volatile("" : "+v"(tid)); const int lane = tid & 63, wave = __builtin_amdgcn_readfirstlane(tid >> 6); const int gw = vcu * NWAVES + wave, gt = bid * NTHR + tid; (void)lane; (void)gw; (void)gt;
    unsigned char* ws = a.ws; unsigned char* wb = ws + WS_W;
    float* X = a.out; const float* MODB = (const float*)(ws + WS_MOD);
    const bf16* H = (const bf16*)(ws + WS_H);

    if (threadIdx.x < 64) ((LAS unsigned*)(lds + 131072))[threadIdx.x] = 0u;
    __syncthreads();
    XcdBarrier xbar = xcd_barrier_post((unsigned*)(ws + WS_BAR), (volatile LAS unsigned*)(lds + 131072));
#define GSYNC() xcd_barrier(xbar)
    constexpr bool split2 = true;
#define OPQ_S(v) asm volatile("" : "+s"(v))
#define PHV() int bid = blockIdx.x; OPQ_S(bid); size_t wz_ = 0; OPQ_S(wz_); unsigned char* ws = a.ws + wz_; unsigned char* wb = ws + WS_W; const bf16* H = (const bf16*)(ws + WS_H); float* X = a.out; (void)bid; (void)wb; (void)H; (void)X;
    { TIDS(); adaln_phase(a, lds, tid);
    __syncthreads();
    convert_phase(a, 0, lds, gw, ngw, wave, lane); }
    grid.sync();
#pragma unroll 1
    for (int l = 0; l < 2; ++l) {
        const float* mod = MODB + (size_t)l * 9 * 9216;
        if (l == 1) { TIDS(); convert_phase(a, 1, lds, gw, ngw, wave, lane); }
#pragma unroll 1
        for (int f = 0; f < 2; ++f) {
            if (f == 1) {
                { TIDS(); normmod_phase(a, l, 1, false, split2, gw, ngw, lane);
                  float* rss = (float*)(a.ws + WS_ROWSS); for (int i = gt; i < T_ALL; i += ngt) rss[i] = 0.f; }
                GSYNC();
#pragma unroll 1
                for (int hs = 0; hs < 2; ++hs) {
                    const int npc = hs ? 2 : 1;
#pragma unroll 1
                    for (int pc = 0; pc < npc; ++pc) {
                        const int tb = hs ? (pc ? 0 : 16384) : 1280, tcnt = hs ? (pc ? 1280 : 20480) : 15104, ro = (hs && !pc) ? 1280 : 0;
                        PHV(); const int cc = (hs && pc) ? ((bid >= 128 && bid < 193) ? bid - 128 : (1 << 20)) : bid;
                        pg8::Gemm g{H + (size_t)tb * DM, (const bf16*)(wb + WO_WINA), tcnt, NA_ROWS, DM, DM, DM, 0}; pg8::StaticOrder S; S.init(tcnt, NA_ROWS, G, cc);
                        pg8::EpiStore E{(bf16*)(ws + WS_RB) + (size_t)ro * CONVD, CONVD, 12, (float*)(ws + WS_DT) + (size_t)tb * 64, a.in[19] + (size_t)l * 64, 0, 0};
                        pg8::gemm_phase<pg8::EpiStore, pg8::StaticOrder>(lds, g, S, E);
                    }
                    GSYNC();
#pragma unroll 1
                    for (int pc = 0; pc < npc; ++pc) {
                        const int tb = hs ? (pc ? 0 : 16384) : 1280, tcnt = hs ? (pc ? 1280 : 20480) : 15104, ro = (hs && !pc) ? 1280 : 0;
                        TIDS(); conv_phase(a, l, tb, tcnt, ro, gw, ngw, lane);
                    }
                    GSYNC();
                }
                { TIDS(); ssd_phase(a, l, lds, vcu, G, tid, wave, lane); }
                GSYNC();
                { PHV(); pg8::Gemm g{H, (const bf16*)(wb + WO_WINB), T_ALL, DIN, DM, DM, DM, 0}; pg8::StaticOrder S; S.init(T_ALL, DIN, G, bid);
                  pg8::EpiYZ E{(bf16*)(ws + WS_RB), DIN, (float*)(ws + WS_ROWSS)};
                  pg8::gemm_phase<pg8::EpiYZ, pg8::StaticOrder>(lds, g, S, E); }
                GSYNC();
                { PHV(); pg8::Gemm g{H, (const bf16*)(wb + WO_WINB) + (size_t)DIN * DM, T_ALL, 3 * DM, DM, DM, DM, 0}; pg8::StaticOrder S; S.init(T_ALL, 3 * DM, G, bid);
                  pg8::EpiStore E{(bf16*)(ws + WS_RA + RA_U), DM, -1, nullptr, nullptr, 4, (size_t)T_ALL * DM};
                  pg8::gemm_phase<pg8::EpiStore, pg8::StaticOrder>(lds, g, S, E); }
                GSYNC();
                { TIDS(); hpool_phase(a, gt, ngt); }
                GSYNC();
                { TIDS(); vpool_phase(a, gt, ngt); }
                GSYNC();
                { PHV(); pg8::Gemm g{(const bf16*)(ws + WS_RB), (const bf16*)(wb + WO_WBS), T_ALL, DM, DIN, DIN, DIN, 0}; pg8::StaticOrder S; S.init(T_ALL, DM, G, bid);
                  pg8::EpiGate<3> E{(bf16*)(ws + WS_RA + RA_GB), DM, nullptr, (const bf16*)(ws + WS_RA + RA_GB), DM, (const float*)(ws + WS_ROWSS)};
                  pg8::gemm_phase<pg8::EpiGate<3>, pg8::StaticOrder>(lds, g, S, E); }
                { PHV(); const int nl = G / 4; pg8::Gemm g{(const bf16*)(ws + WS_RA + RA_U), (const bf16*)(wb + WO_PW), T_ALL, DM, 256, DM, 256, 512}; pg8::StaticOrder S; S.init(T_ALL, DM, G - nl, bid >= nl ? bid - nl : (1 << 20));
                  pg8::EpiGate<0> E{(bf16*)(ws + WS_H), DM, a.in[15] + (size_t)l * DM, nullptr, 0, nullptr};
                  pg8::gemm_phase<pg8::EpiGate<0>, pg8::StaticOrder>(lds, g, S, E); }
                GSYNC();
                { PHV(); pg8::Gemm g{H, (const bf16*)(wb + WO_WBP), T_ALL, DM, DM, DM, DM, 0}; pg8::StaticOrder S; S.init(T_ALL, DM, G, bid);
                  pg8::EpiGate<2> E{(bf16*)(ws + WS_RA + RA_GB), DM, nullptr, (const bf16*)(ws + WS_RA + RA_GA), DM, nullptr};
                  pg8::gemm_phase<pg8::EpiGate<2>, pg8::StaticOrder>(lds, g, S, E); }
                GSYNC();
                { PHV(); pg8::Gemm g{(const bf16*)(ws + WS_RA + RA_GB), (const bf16*)(wb + WO_WO), T_ALL, DM, DM, DM, DM, 0}; pg8::StaticOrder S; S.init(T_ALL, DM, G, bid);
                  pg8::EpiResid E{(const bf16*)X, (bf16*)X, a.in[0], a.in[1], mod, 5 * DM, 1.0f, 0, 0};
                  pg8::gemm_phase<pg8::EpiResid, pg8::StaticOrder>(lds, g, S, E); }
                GSYNC();
            }
            const bool use_in = (l == 0 && f == 0);
            { TIDS(); normmod_phase(a, l, f ? 2 : 0, use_in, split2 && f == 0 && l == 1, gw, ngw, lane); }
            GSYNC();
            { PHV(); pg8::Gemm g{H, (const bf16*)(wb + (f ? WO_W13B : WO_W13A)), T_ALL, 2 * DFF, DM, DM, DM, 0}; pg8::StaticOrder S; S.init(T_ALL, 2 * DFF, G, bid);
              pg8::EpiSwiGLU E{(bf16*)(ws + WS_RA), DFF};
              pg8::gemm_phase<pg8::EpiSwiGLU, pg8::StaticOrder>(lds, g, S, E); }
            GSYNC();
            {
              { PHV(); pg8::Gemm g{(const bf16*)(ws + WS_RA), (const bf16*)(wb + (f ? WO_W2B : WO_W2A)), T_ALL, DM, DFF, DFF, DFF, 0}; pg8::PanelOrder S{0, bid};
                pg8::EpiResid E{(const bf16*)X, (l == 1 && f == 1) ? (bf16*)(ws + WS_RB) : (bf16*)X, a.in[0], a.in[1], mod, (f ? 8 : 2) * DM, 0.5f, 0, use_in ? 1 : 0};
                pg8::gemm_phase<pg8::EpiResid, pg8::PanelOrder>(lds, g, S, E); }
              { PHV(); pg8::Gemm g{(const bf16*)(ws + WS_RA), (const bf16*)(wb + (f ? WO_W2B : WO_W2A)), T_ALL, DM, DFF / 2, DFF, DFF, 0}; pg8::PanelOrder S{1, bid};
                pg8::EpiResid E{(const bf16*)X, (l == 1 && f == 1) ? (bf16*)(ws + WS_RB) : (bf16*)X, a.in[0], a.in[1], mod, (f ? 8 : 2) * DM, 0.5f, 0, use_in ? 1 : 0};
                pg8::gemm_phase<pg8::EpiResid, pg8::PanelOrder>(lds, g, S, E); }
              { PHV(); pg8::Gemm g{(const bf16*)(ws + WS_RA) + DFF / 2, (const bf16*)(wb + (f ? WO_W2B : WO_W2A)) + DFF / 2, T_ALL, DM, DFF / 2, DFF, DFF, 0}; pg8::PanelOrder S{1, bid - 64};
                pg8::EpiDelta E{(bf16*)(ws + WS_D2), mod, (f ? 8 : 2) * DM, 0.5f};
                pg8::gemm_phase<pg8::EpiDelta, pg8::PanelOrder>(lds, g, S, E); }
            }
            GSYNC();
        }
    }
    { TIDS(); final_norm_phase(a, split2, gw, ngw, lane); }
}

extern "C" void kernel_launch(void* const* d_in, const int* in_sizes, int n_in, void* d_out, int out_size, void* d_ws, size_t ws_size, hipStream_t stream) {
    static int grid = 0;
    if (grid == 0) {
        if (n_in != 26 || ws_size < WS_END) { fprintf(stderr, "kernel_launch: unexpected n_in %d / ws_size %zu\n", n_in, ws_size); grid = -1; return; }
        int dev = 0, cus = 0, per_cu = 0;
        hipGetDevice(&dev);
        hipDeviceGetAttribute(&cus, hipDeviceAttributeMultiprocessorCount, dev);
        if (hipFuncSetAttribute((const void*)hybrid_fwd, hipFuncAttributeMaxDynamicSharedMemorySize, LDS_BYTES) != hipSuccess) { fprintf(stderr, "kernel_launch: hipFuncSetAttribute failed\n"); }
        if (hipOccupancyMaxActiveBlocksPerMultiprocessor(&per_cu, (const void*)hybrid_fwd, NTHR, LDS_BYTES) != hipSuccess || per_cu < 1) { fprintf(stderr, "kernel_launch: occupancy query gave %d\n", per_cu); per_cu = 1; }
        (void)hipGetLastError();
        grid = cus;
        if (grid != 256) { fprintf(stderr, "kernel_launch: built for a 256-CU device (got %d); nothing launched\n", grid); grid = -1; return; }
    }
    if (grid < 0) return;
    Args a{};
    for (int i = 0; i < 26; ++i) a.in[i] = (const float*)d_in[i];
    a.out = (float*)d_out; a.ws = (unsigned char*)d_ws;
    if (hipMemsetAsync((char*)d_ws + WS_BAR, 0, BAR_ZERO_BYTES, stream) != hipSuccess) { fprintf(stderr, "kernel_launch: memset failed\n"); return; }
    void* args[] = {&a};
    hipError_t e = hipLaunchCooperativeKernel((const void*)hybrid_fwd, dim3(grid), dim3(NTHR), args, LDS_BYTES, stream);
    if (e != hipSuccess) fprintf(stderr, "cooperative launch failed: %s (grid %d)\n", hipGetErrorString(e), grid);
}
```
